# Optimizing an MI355X kernel written in HIP

```python
import math
import jax, jax.numpy as jnp
from jax import lax
import numpy as np

D_MODEL = 1024
BATCH = 2
SEQ = 8192
DEPTH = 4
DEC_BATCH = 32
DEC_SEQ = 4
PAST_LEN = 8192
PAGE_SIZE = 128

N_AB = (DEPTH + 1) // 2
N_CL = DEPTH // 2
EPS = 1e-6
ML_HEADS = 4
ML_DIM = D_MODEL // 8
ML_WIDTH = ML_HEADS * ML_DIM
CONV_W = 4
ML_CHUNK = 64
NSA_HEADS = 8
NSA_KV = 2
NSA_GROUP = NSA_HEADS // NSA_KV
NSA_DIM = D_MODEL // 16
CMP_LEN = 32
CMP_STRIDE = 16
CMP_PIECES = CMP_LEN // CMP_STRIDE
PHI_HIDDEN = D_MODEL // 16
SEL_BLOCK = 64
N_SEL = 16
WINDOW = 512
NSA_QB = 64
MIX_WIDTH = ML_WIDTH + NSA_HEADS * NSA_DIM
AB_SIZES = (ML_WIDTH, ML_WIDTH, ML_WIDTH, ML_WIDTH, ML_HEADS, ML_HEADS,
            NSA_HEADS * NSA_DIM, 6 * NSA_KV * NSA_DIM, 3 * NSA_HEADS)
AB_IN = sum(AB_SIZES)
GM_WIDTH = D_MODEL
GM_GROUPS = 4
GM_CHUNK = 128
FFN = 4 * D_MODEL

kernel_name = 'hybrid_mlstm_nsa_gmlp_step'


def rmsnorm(x, g):
    xf = x.astype(jnp.float32)
    y = xf * lax.rsqrt(jnp.mean(xf * xf, axis=-1, keepdims=True) + EPS)
    return (y * g.astype(jnp.float32)).astype(x.dtype)


def masked_softmax(s, mask):
    s = jnp.where(mask, s.astype(jnp.float32), -jnp.inf)
    m = jnp.max(s, axis=-1, keepdims=True)
    p = jnp.exp(s - jnp.where(jnp.isfinite(m), m, 0.0))
    d = jnp.sum(p, axis=-1, keepdims=True)
    return p / jnp.where(d > 0, d, 1.0)


def causal_conv(x, buf, w, b):
    T = x.shape[1]
    xp = jnp.concatenate([buf.astype(x.dtype), x], axis=1)
    y = b
    for j in range(CONV_W):
        y = y + xp[:, j:j + T] * w[j]
    return y, xp[:, T:]


def mlstm_scan(q, k, v, log_i, log_f, C0, n0, m0):
    B, T, H, D = q.shape
    L = math.gcd(ML_CHUNK, T)
    nc = T // L
    f32 = jnp.float32

    def chunks(a):
        return jnp.moveaxis(a.astype(f32).reshape((B, nc, L) + a.shape[2:]), 1, 0)

    causal = jnp.tril(jnp.ones((L, L), dtype=bool))[None, :, :, None]

    def step(carry, xs):
        C, n, m = carry
        qc, kc, vc, lic, lfc = xs
        b = jnp.cumsum(lfc, axis=1)
        a = m[:, None] + b
        dmat = jnp.where(causal, b[:, :, None] - b[:, None] + lic[:, None], -jnp.inf)
        mt = jnp.maximum(a, dmat.max(axis=2))
        w_inter = jnp.exp(a - mt)
        qk = jnp.einsum('bthd,bshd->btsh', qc, kc) * jnp.exp(dmat - mt[:, :, None])
        num = w_inter[..., None] * jnp.einsum('bthd,bhde->bthe', qc, C) + jnp.einsum('btsh,bshe->bthe', qk, vc)
        den = w_inter * jnp.einsum('bthd,bhd->bth', qc, n) + qk.sum(axis=2)
        h = num / jnp.maximum(jnp.abs(den), jnp.exp(-mt))[..., None]
        bl = b[:, -1]
        g = bl[:, None] - b + lic
        m_new = jnp.maximum(m + bl, g.max(axis=1))
        decay = jnp.exp(m + bl - m_new)
        ws = jnp.exp(g - m_new[:, None])
        C_new = decay[..., None, None] * C + jnp.einsum('bsh,bshd,bshe->bhde', ws, kc, vc)
        n_new = decay[..., None] * n + jnp.einsum('bsh,bshd->bhd', ws, kc)
        return (C_new, n_new, m_new), h

    (C, n, m), h = lax.scan(step, (C0.astype(f32), n0.astype(f32), m0.astype(f32)),
                            tuple(chunks(a) for a in (q, k, v, log_i, log_f)))
    return jnp.moveaxis(h, 0, 1).reshape(B, T, H, D), C, n, m


def compress_blocks(k, pe, w1, b1, w2, b2):
    B, TK, G, hd = k.shape
    n_sub = TK // CMP_STRIDE
    nc = n_sub - CMP_PIECES + 1
    sub = k[:, :n_sub * CMP_STRIDE].reshape(B, n_sub, CMP_STRIDE, G, hd)
    pre = b1
    piece_w = CMP_STRIDE * hd
    for r in range(CMP_PIECES):
        piece = sub + pe[r * CMP_STRIDE:(r + 1) * CMP_STRIDE][:, None, :]
        piece = jnp.swapaxes(piece, 2, 3).reshape(B, n_sub, G, piece_w)
        pre = pre + (piece @ w1[r * piece_w:(r + 1) * piece_w])[:, r:r + nc]
    return jax.nn.gelu(pre) @ w2 + b2


def to_blocks(k, nb):
    B, TK, G, hd = k.shape
    k = jnp.pad(k, ((0, 0), (0, nb * SEL_BLOCK - TK), (0, 0), (0, 0)))
    return k.reshape(B, nb, SEL_BLOCK, G, hd).transpose(0, 3, 1, 2, 4)


def nsa_attend(q, g, qpos, kc, vc, c_end, ovl, ks_bg, vs_bg, kw, vw, kwpos):
    B, Q = q.shape[:2]
    scale = NSA_DIM ** -0.5
    dt = vc.dtype
    s = jnp.einsum('bqgrd,bngd->bqgrn', q, kc) * scale
    p_cmp = masked_softmax(s, (c_end[None, :] <= qpos[:, None])[None, :, None, None, :])
    o_cmp = jnp.einsum('bqgrn,bngd->bqgrd', p_cmp.astype(dt), vc)
    nb = ks_bg.shape[2]
    imp = jnp.einsum('bqgn,nj->bqgj', p_cmp.sum(axis=3), ovl)
    blk = jnp.arange(nb)
    cur = qpos // SEL_BLOCK
    avail = blk[None, :] * SEL_BLOCK <= qpos[:, None]
    forced = (blk[None, :] == 0) | (blk[None, :] == cur[:, None]) | (blk[None, :] == cur[:, None] - 1)
    imp = jnp.where(avail[None, :, None], jnp.where(forced[None, :, None], jnp.inf, imp), -jnp.inf)
    _, idx = lax.top_k(imp, min(N_SEL, nb))
    n_sel = idx.shape[-1]
    bi = jnp.arange(B)[:, None, None, None]
    gi = jnp.arange(NSA_KV)[None, None, :, None]
    k_sel = ks_bg[bi, gi, idx].reshape(B, Q, NSA_KV, n_sel * SEL_BLOCK, NSA_DIM)
    v_sel = vs_bg[bi, gi, idx].reshape(B, Q, NSA_KV, n_sel * SEL_BLOCK, NSA_DIM)
    kpos = (idx[..., None] * SEL_BLOCK + jnp.arange(SEL_BLOCK)).reshape(B, Q, NSA_KV, 1, n_sel * SEL_BLOCK)
    s = jnp.einsum('bqgrd,bqgmd->bqgrm', q, k_sel) * scale
    p = masked_softmax(s, kpos <= qpos[None, :, None, None, None])
    o_slc = jnp.einsum('bqgrm,bqgmd->bqgrd', p.astype(dt), v_sel)
    s = jnp.einsum('bqgrd,blgd->bqgrl', q, kw) * scale
    wmask = (kwpos[None, :] <= qpos[:, None]) & (kwpos[None, :] >= qpos[:, None] - WINDOW) & (kwpos[None, :] >= 0)
    p = masked_softmax(s, wmask[None, :, None, None, :])
    o_win = jnp.einsum('bqgrl,blgd->bqgrd', p.astype(dt), vw)
    o = g[..., 0:1] * o_cmp + g[..., 1:2] * o_slc + g[..., 2:3] * o_win
    return o.reshape(B, Q, NSA_HEADS * NSA_DIM)


def ab_mixer(h, W, j, st, page_table):
    B, T, _ = h.shape
    dt = h.dtype
    splits = np.cumsum(AB_SIZES)[:-1].tolist()
    (q_pre, k_pre, v_m, o_pre, i_pre, f_pre, q_n, kv_n, g_n) = jnp.split(
        h @ W['ab_w_in'][j] + W['ab_b_in'][j], splits, axis=-1)
    if st is None:
        conv_buf = jnp.zeros((B, CONV_W - 1, 2 * ML_WIDTH), dt)
        C0 = jnp.zeros((B, ML_HEADS, ML_DIM, ML_DIM), jnp.float32)
        n0 = jnp.zeros((B, ML_HEADS, ML_DIM), jnp.float32)
        m0 = jnp.zeros((B, ML_HEADS), jnp.float32)
    else:
        conv_buf, C0, n0, m0, kv_cache, win_buf = st
    qk, conv_new = causal_conv(jnp.concatenate([q_pre, k_pre], axis=-1), conv_buf,
                               W['ml_conv_w'][j], W['ml_conv_b'][j])
    qm, km = jnp.split(jax.nn.silu(qk), 2, axis=-1)
    heads = lambda a: a.reshape(B, T, ML_HEADS, ML_DIM)
    log_f = jax.nn.log_sigmoid((f_pre + W['ml_f_bias'][j]).astype(jnp.float32))
    hm, C1, n1, m1 = mlstm_scan(heads(qm), heads(km) * (ML_DIM ** -0.5), heads(v_m), i_pre, log_f, C0, n0, m0)
    hm = rmsnorm(hm.astype(dt), W['ml_out_g'][j].reshape(ML_HEADS, ML_DIM)).reshape(B, T, ML_WIDTH)
    hm = hm * jax.nn.sigmoid(o_pre)
    qn = q_n.reshape(B, T, NSA_KV, NSA_GROUP, NSA_DIM)
    gn = jax.nn.sigmoid(g_n).reshape(B, T, NSA_KV, NSA_GROUP, 3)
    kv = kv_n.reshape(B, T, 6, NSA_KV, NSA_DIM)
    kv_rows, win_rows = kv[:, :, :4], kv[:, :, 4:]
    if st is None:
        past = 0
        full = kv_rows
    else:
        past = page_table.shape[1] * PAGE_SIZE
        gathered = kv_cache[page_table].reshape((B, past) + kv_rows.shape[2:]).astype(dt)
        full = jnp.concatenate([gathered, kv_rows], axis=1)
    tk = past + T
    kc = compress_blocks(full[:, :, 0], W['phi_pe'][j, 0], W['phi_w1'][j, 0], W['phi_b1'][j, 0],
                         W['phi_w2'][j, 0], W['phi_b2'][j, 0])
    vc = compress_blocks(full[:, :, 1], W['phi_pe'][j, 1], W['phi_w1'][j, 1], W['phi_b1'][j, 1],
                         W['phi_w2'][j, 1], W['phi_b2'][j, 1])
    nc = kc.shape[1]
    c_start = jnp.arange(nc) * CMP_STRIDE
    c_end = c_start + CMP_LEN - 1
    nb = -(-tk // SEL_BLOCK)
    b_start = jnp.arange(nb) * SEL_BLOCK
    ovl = ((c_start[:, None] < b_start[None, :] + SEL_BLOCK) &
           (c_start[:, None] + CMP_LEN > b_start[None, :])).astype(jnp.float32)
    ks_bg = to_blocks(full[:, :, 2], nb)
    vs_bg = to_blocks(full[:, :, 3], nb)
    if st is None:
        qb = math.gcd(NSA_QB, T)
        win_pad = jnp.pad(win_rows, ((0, 0), (WINDOW, 0), (0, 0), (0, 0), (0, 0)))

        def block(i):
            s0 = i * qb
            wb = lax.dynamic_slice_in_dim(win_pad, s0, WINDOW + qb, axis=1)
            return nsa_attend(lax.dynamic_slice_in_dim(qn, s0, qb, axis=1),
                              lax.dynamic_slice_in_dim(gn, s0, qb, axis=1),
                              s0 + jnp.arange(qb), kc, vc, c_end, ovl, ks_bg, vs_bg,
                              wb[:, :, 0], wb[:, :, 1], s0 - WINDOW + jnp.arange(WINDOW + qb))

        o_nsa = lax.map(block, jnp.arange(T // qb))
        o_nsa = jnp.moveaxis(o_nsa, 0, 1).reshape(B, T, NSA_HEADS * NSA_DIM)
        win_new = win_rows[:, -min(WINDOW, T):]
    else:
        wk = jnp.concatenate([win_buf.astype(dt), win_rows], axis=1)
        wb_len = win_buf.shape[1]
        kwpos = past - wb_len + jnp.arange(wb_len + T)
        o_nsa = nsa_attend(qn, gn, past + jnp.arange(T), kc, vc, c_end, ovl, ks_bg, vs_bg,
                           wk[:, :, 0], wk[:, :, 1], kwpos)
        win_new = wk[:, -wb_len:]
    y = jnp.concatenate([hm, o_nsa], axis=-1) @ W['ab_w_out'][j]
    return y, (conv_new, C1, n1, m1, kv_rows, win_new)


def cl_mixer(h, W, j):
    B, T, _ = h.shape
    z = jax.nn.gelu(h @ W['cl_w_in'][j] + W['cl_b_in'][j])
    u, v = jnp.split(z, 2, axis=-1)
    v = rmsnorm(v, W['cl_v_g'][j])
    L = min(GM_CHUNK, T)
    vr = v.reshape(B, T // L, L, GM_GROUPS, GM_WIDTH // GM_GROUPS)
    ws = jnp.where(jnp.tril(jnp.ones((L, L), dtype=bool))[None], W['cl_ws'][j][:, :L, :L], 0.0)
    s = jnp.einsum('gts,bcsgd->bctgd', ws, vr) + W['cl_bs'][j][:, :L].T[None, None, :, :, None]
    y = (u * s.reshape(B, T, GM_WIDTH)) @ W['cl_w_out'][j]
    return y, v


def ffn(h, w1, w2):
    return jnp.square(jax.nn.relu(h @ w1)) @ w2


def trunk(x, c, W, state, page_table):
    B = x.shape[0]
    sc = jax.nn.silu(c)
    ab_new, cl_new = [], []
    for l in range(DEPTH):
        mod = (sc @ W['ada_w'][l] + W['ada_b'][l]).reshape(B, 6, 1, D_MODEL)
        h = rmsnorm(x, W['norm_g'][l, 0]) * (1 + mod[:, 1]) + mod[:, 0]
        if l % 2 == 0:
            st = None if state is None else tuple(a[l // 2] for a in state)
            y, new = ab_mixer(h, W, l // 2, st, page_table)
            ab_new.append(new)
        else:
            y, new = cl_mixer(h, W, l // 2)
            cl_new.append(new)
        x = x + mod[:, 2] * y
        h = rmsnorm(x, W['norm_g'][l, 1]) * (1 + mod[:, 4]) + mod[:, 3]
        x = x + mod[:, 5] * ffn(h, W['ffn_w1'][l], W['ffn_w2'][l])
    return rmsnorm(x, W['final_g']), ab_new, cl_new


def setup_inputs(seed: int = 0) -> dict:
    key = jax.random.key(seed)
    ks = iter(jax.random.split(key, 48))
    D = D_MODEL

    def nrm(shape, s=1.0):
        return s * jax.random.normal(next(ks), shape, jnp.float32)

    n_pages = PAST_LEN // PAGE_SIZE
    n_pool = (5 * DEC_BATCH * n_pages) // 4
    win_buf = min(WINDOW, PAST_LEN)
    page_table = jax.random.permutation(next(ks), n_pool)[:DEC_BATCH * n_pages]
    page_table = page_table.reshape(DEC_BATCH, n_pages).astype(jnp.int32)
    return {
        'x_prompt': nrm((BATCH, SEQ, D)),
        'x_sample': nrm((DEC_BATCH, DEC_SEQ, D)),
        'c_prompt': nrm((BATCH, D)),
        'c_sample': nrm((DEC_BATCH, D)),
        'state_mlstm_conv': nrm((N_AB, DEC_BATCH, CONV_W - 1, 2 * ML_WIDTH)),
        'state_mlstm_C': nrm((N_AB, DEC_BATCH, ML_HEADS, ML_DIM, ML_DIM), 0.1),
        'state_mlstm_n': nrm((N_AB, DEC_BATCH, ML_HEADS, ML_DIM), 0.1),
        'state_mlstm_m': nrm((N_AB, DEC_BATCH, ML_HEADS)),
        'cache_nsa_kv': nrm((N_AB, n_pool, PAGE_SIZE, 4, NSA_KV, NSA_DIM)),
        'state_nsa_win': nrm((N_AB, DEC_BATCH, win_buf, 2, NSA_KV, NSA_DIM)),
        'page_table': page_table,
        'ada_w': nrm((DEPTH, D, 6 * D), 0.5 * D ** -0.5),
        'ada_b': nrm((DEPTH, 6 * D), 0.02),
        'norm_g': 1.0 + nrm((DEPTH, 2, D), 0.02),
        'ab_w_in': nrm((N_AB, D, AB_IN), D ** -0.5),
        'ab_b_in': nrm((N_AB, AB_IN), 0.02),
        'ml_conv_w': nrm((N_AB, CONV_W, 2 * ML_WIDTH), CONV_W ** -0.5),
        'ml_conv_b': nrm((N_AB, 2 * ML_WIDTH), 0.02),
        'ml_f_bias': jax.random.uniform(next(ks), (N_AB, ML_HEADS), jnp.float32, 3.0, 6.0),
        'ml_out_g': 1.0 + nrm((N_AB, ML_WIDTH), 0.02),
        'phi_pe': nrm((N_AB, 2, CMP_LEN, NSA_DIM), 0.1),
        'phi_w1': nrm((N_AB, 2, CMP_LEN * NSA_DIM, PHI_HIDDEN), (CMP_LEN * NSA_DIM) ** -0.5),
        'phi_b1': nrm((N_AB, 2, PHI_HIDDEN), 0.02),
        'phi_w2': nrm((N_AB, 2, PHI_HIDDEN, NSA_DIM), PHI_HIDDEN ** -0.5),
        'phi_b2': nrm((N_AB, 2, NSA_DIM), 0.02),
        'ab_w_out': nrm((N_AB, MIX_WIDTH, D), MIX_WIDTH ** -0.5),
        'cl_w_in': nrm((N_CL, D, 2 * GM_WIDTH), D ** -0.5),
        'cl_b_in': nrm((N_CL, 2 * GM_WIDTH), 0.02),
        'cl_v_g': 1.0 + nrm((N_CL, GM_WIDTH), 0.02),
        'cl_ws': nrm((N_CL, GM_GROUPS, GM_CHUNK, GM_CHUNK), GM_CHUNK ** -0.5),
        'cl_bs': 1.0 + nrm((N_CL, GM_GROUPS, GM_CHUNK), 0.1),
        'cl_w_out': nrm((N_CL, GM_WIDTH, D), GM_WIDTH ** -0.5),
        'ffn_w1': nrm((DEPTH, D, FFN), D ** -0.5),
        'ffn_w2': nrm((DEPTH, FFN, D), FFN ** -0.5),
        'final_g': 1.0 + nrm((D,), 0.02),
    }


def reference(x_prompt, x_sample, c_prompt, c_sample, state_mlstm_conv, state_mlstm_C, state_mlstm_n,
              state_mlstm_m, cache_nsa_kv, state_nsa_win, page_table, ada_w, ada_b, norm_g, ab_w_in, ab_b_in,
              ml_conv_w, ml_conv_b, ml_f_bias, ml_out_g, phi_pe, phi_w1, phi_b1, phi_w2, phi_b2, ab_w_out,
              cl_w_in, cl_b_in, cl_v_g, cl_ws, cl_bs, cl_w_out, ffn_w1, ffn_w2, final_g):
    W = dict(ada_w=ada_w, ada_b=ada_b, norm_g=norm_g, ab_w_in=ab_w_in, ab_b_in=ab_b_in,
             ml_conv_w=ml_conv_w, ml_conv_b=ml_conv_b, ml_f_bias=ml_f_bias, ml_out_g=ml_out_g,
             phi_pe=phi_pe, phi_w1=phi_w1, phi_b1=phi_b1, phi_w2=phi_w2, phi_b2=phi_b2, ab_w_out=ab_w_out,
             cl_w_in=cl_w_in, cl_b_in=cl_b_in, cl_v_g=cl_v_g, cl_ws=cl_ws, cl_bs=cl_bs, cl_w_out=cl_w_out,
             ffn_w1=ffn_w1, ffn_w2=ffn_w2, final_g=final_g)
    y_prompt, ab_p, _ = trunk(x_prompt, c_prompt, W, None, None)
    state = (state_mlstm_conv, state_mlstm_C, state_mlstm_n, state_mlstm_m, cache_nsa_kv, state_nsa_win)
    y_sample, ab_s, cl_s = trunk(x_sample, c_sample, W, state, page_table)
    p_conv, p_C, p_n, p_m, p_kv, p_win = [jnp.stack(a) for a in zip(*ab_p)]
    s_conv, s_C, s_n, s_m, s_kv, s_win = [jnp.stack(a) for a in zip(*ab_s)]
    s_gmlp_v = jnp.stack(cl_s)
    return (y_prompt, y_sample, p_conv, p_C, p_n, p_m, p_kv, p_win,
            s_conv, s_C, s_n, s_m, s_kv, s_win, s_gmlp_v)
```

```cpp
#include <hip/hip_runtime.h>
#include <cstdio>
#include <cstdint>
namespace pg8 {
#define PG8_LAS __attribute__((address_space(3)))
typedef unsigned short bf16_t;
typedef short bf16x8 __attribute__((ext_vector_type(8)));
typedef float f32x4 __attribute__((ext_vector_type(4)));
typedef unsigned u32x4 __attribute__((ext_vector_type(4)));
constexpr int BM = 256, BK = 64, HALF = 128, HTB = HALF * BK * 2  , STAGE_BYTES = 8 * HTB, NXCD = 8, WGM = 8;

__host__ __device__ __forceinline__ int lds_byte(int r, int c) { const int st = (r >> 4) * 2 + (c >> 5), rr = r & 15, cc = c & 31, ob = rr * 64 + cc * 2; return st * 1024 + (ob ^ (((ob >> 9) & 1) << 5)); }
__host__ __device__ __forceinline__ void stage_rc(int b, int& R, int& C) { const int st = b / 1024, sb = b % 1024, swz = sb ^ (((sb >> 9) & 1) << 5); R = (st >> 1) * 16 + swz / 64; C = (st & 1) * 32 + (swz % 64) / 2; }
__host__ __device__ __forceinline__ int perm32(int rho) { const int n = rho >> 4, i = rho & 15; return 8 * (i >> 2) + 4 * n + (i & 3); }

struct Unit { int pm, pn; };
struct Gemm { const bf16_t* A; const bf16_t* Bt; int M, N, K; };

struct StaticOrder {
    int nM, nN, nwg, G, c;
    __host__ __device__ void init(int M, int N, int G_, int c_) { nM = M / BM; nN = N / BM; nwg = nM * nN; G = G_; c = c_; }
    __host__ __device__ bool next(int i, Unit& u) const {
        const long L = (long)i * G + c; if (L >= nwg) return false;
        int wgid = (int)L; { const int q = nwg / NXCD, r = nwg % NXCD, xcd = wgid % NXCD, off = wgid / NXCD; wgid = (xcd < r ? xcd * (q + 1) : r * (q + 1) + (xcd - r) * q) + off; }
        const int nig = WGM * nN, gid = wgid / nig, fm = gid * WGM, gsz = (nM - fm) < WGM ? (nM - fm) : WGM;
        u.pm = fm + ((wgid % nig) % gsz); u.pn = (wgid % nig) / gsz; return true;
    }
    __device__ __forceinline__ void a_ready(const Unit&) const {}
    __device__ __forceinline__ void done(const Unit&) const {}
};

__device__ __forceinline__ unsigned cvt_pk_bf16(float lo, float hi) { unsigned r; asm volatile("v_cvt_pk_bf16_f32 %0, %1, %2" : "=v"(r) : "v"(lo), "v"(hi)); return r; }
typedef float f32x2 __attribute__((ext_vector_type(2)));

template <class Epi, class Sched, bool ALIGN_EPI = false, bool SP2 = false>
__device__ __forceinline__ void gemm_phase(PG8_LAS unsigned char* lds, const Gemm g, const Sched& S, const Epi& E) {
    int tid_ = threadIdx.x; asm volatile("" : "+v"(tid_));
    const int tid = tid_, wid = __builtin_amdgcn_readfirstlane(tid >> 6), lane = tid & 63, wr = wid >> 2, wc = wid & 3, fr = lane & 15, fq = lane >> 4;
    const int K = g.K, nt = K / BK;
    unsigned voffA[2], voffB[2];
#pragma unroll
    for (int i = 0; i < 2; ++i) { int R, C; stage_rc(tid * 16 + i * 8192, R, C); const int Rb = Epi::PERM ? ((R & ~31) + perm32(R & 31)) : R;
        voffA[i] = (unsigned)(R * K + C) * 2u; voffB[i] = (unsigned)(Rb * K + C) * 2u; }
    const size_t kstep = (size_t)(BK * 2);
    const size_t hstep = (size_t)HALF * K * 2;
    const size_t tstep = 2 * hstep;
    const unsigned ldsw = (unsigned)wid * 1024u;
    const int aoff = lds_byte(wr * 64 + fr, fq * 8), boff = lds_byte(wc * 32 + fr, fq * 8);
#define PG8_SA(b, h) (((b) * 2 + (h)) * HTB)
#define PG8_SB(b, h) ((4 + (b) * 2 + (h)) * HTB)
#define PG8_STAGE(bufoff, gbase, voff) do { _Pragma("unroll") for (int _i = 0; _i < 2; ++_i) \
        __builtin_amdgcn_global_load_lds((const unsigned*)((const char*)(gbase) + (voff)[_i]), (PG8_LAS unsigned*)(lds + (bufoff) + ldsw + _i * 8192), 16, 0, 0); } while (0)
#define PG8_LDA(dst, b, h) do { _Pragma("unroll") for (int m = 0; m < 4; ++m) _Pragma("unroll") for (int k = 0; k < 2; ++k) dst[m][k] = *(const PG8_LAS bf16x8*)(lds + PG8_SA(b, h) + aoff + m * 2048 + k * 1024); } while (0)
#define PG8_LDB(dst, b, h) do { _Pragma("unroll") for (int n = 0; n < 2; ++n) _Pragma("unroll") for (int k = 0; k < 2; ++k) dst[n][k] = *(const PG8_LAS bf16x8*)(lds + PG8_SB(b, h) + boff + n * 2048 + k * 1024); } while (0)
#define PG8_MMA(ai, bj, At, Bt) do { __builtin_amdgcn_s_setprio(1); _Pragma("unroll") for (int m = 0; m < 4; ++m) _Pragma("unroll") for (int n = 0; n < 2; ++n) _Pragma("unroll") for (int k = 0; k < 2; ++k) \
        acc[ai][bj][m][n] = __builtin_amdgcn_mfma_f32_16x16x32_bf16(Bt[n][k], At[m][k], acc[ai][bj][m][n], 0, 0, 0); __builtin_amdgcn_s_setprio(0); } while (0)
#define PG8_WAIT_V(n) asm volatile("s_waitcnt vmcnt(" #n ")" ::: "memory")
#define PG8_WAIT_L(n) asm volatile("s_waitcnt lgkmcnt(" #n ")" ::: "memory")
#define PG8_BAR __builtin_amdgcn_s_barrier()
#define PG8_SCHED __builtin_amdgcn_sched_barrier(0)
    Unit cur, nxt; int ui = 0;
    if (!S.next(0, cur)) return;
    f32x4 acc[2][2][4][2];
#pragma unroll
    for (int a = 0; a < 2; ++a)
#pragma unroll
        for (int b = 0; b < 2; ++b)
#pragma unroll
            for (int m = 0; m < 4; ++m)
#pragma unroll
                for (int n = 0; n < 2; ++n) acc[a][b][m][n] = (f32x4){0.f, 0.f, 0.f, 0.f};
    bf16x8 At[4][2], B0[2][2], B1[2][2];
    const char* cA = (const char*)g.A + (size_t)cur.pm * tstep; const char* cB = (const char*)g.Bt + (size_t)cur.pn * tstep;
    S.a_ready(cur);
    if constexpr (SP2) {
        PG8_STAGE(PG8_SB(0, 0), cB, voffB); PG8_STAGE(PG8_SB(0, 1), cB + hstep, voffB); PG8_STAGE(PG8_SA(0, 0), cA, voffA); PG8_STAGE(PG8_SA(0, 1), cA + hstep, voffA);
        if (wr == 1) PG8_BAR;
        PG8_WAIT_V(2); PG8_BAR;
        PG8_STAGE(PG8_SB(1, 0), cB + kstep, voffB); PG8_STAGE(PG8_SA(1, 0), cA + kstep, voffA); PG8_STAGE(PG8_SB(1, 1), cB + hstep + kstep, voffB);
        PG8_WAIT_V(6); PG8_BAR;
    } else {
        PG8_STAGE(PG8_SB(0, 0), cB, voffB); PG8_STAGE(PG8_SA(0, 0), cA, voffA); PG8_STAGE(PG8_SB(0, 1), cB + hstep, voffB); PG8_STAGE(PG8_SA(0, 1), cA + hstep, voffA);
        if (wr == 1) PG8_BAR;
        PG8_WAIT_V(4); PG8_BAR;
        PG8_STAGE(PG8_SB(1, 0), cB + kstep, voffB); PG8_STAGE(PG8_SA(1, 0), cA + kstep, voffA); PG8_STAGE(PG8_SB(1, 1), cB + hstep + kstep, voffB);
        PG8_WAIT_V(6); PG8_BAR;
    }
    for (;;) {
        const bool has_next = S.next(ui + 1, nxt);
        const char* nA = has_next ? (const char*)g.A + (size_t)nxt.pm * tstep : cA; const char* nB = has_next ? (const char*)g.Bt + (size_t)nxt.pn * tstep : cB;
        for (int t = 0; t < nt; t += 2) {
            const bool last = (t == nt - 2);
            const char* a1 = cA + (size_t)(t + 1) * kstep;
            const char* a2 = last ? nA : cA + (size_t)(t + 2) * kstep; const char* b2 = last ? nB : cB + (size_t)(t + 2) * kstep;
            const char* a3 = a2 + kstep; const char* b3 = b2 + kstep;
            if (last && has_next) S.a_ready(nxt);
            if constexpr (SP2) {
            PG8_LDB(B0, 0, 0); PG8_LDB(B1, 0, 1); PG8_SCHED; PG8_LDA(At, 0, 0); PG8_STAGE(PG8_SA(1, 1), a1 + hstep, voffA);
            PG8_WAIT_V(8); PG8_WAIT_L(0); PG8_BAR; PG8_MMA(0, 0, At, B0); PG8_MMA(0, 1, At, B1); PG8_BAR; PG8_SCHED;
            PG8_LDA(At, 0, 1); PG8_STAGE(PG8_SB(0, 0), b2, voffB); PG8_STAGE(PG8_SB(0, 1), b2 + hstep, voffB); PG8_STAGE(PG8_SA(0, 0), a2, voffA);
            PG8_WAIT_V(8); PG8_WAIT_L(0); PG8_BAR; PG8_MMA(1, 0, At, B0); PG8_MMA(1, 1, At, B1); PG8_BAR; PG8_SCHED;
            PG8_LDB(B0, 1, 0); PG8_LDB(B1, 1, 1); PG8_SCHED; PG8_LDA(At, 1, 0); PG8_STAGE(PG8_SA(0, 1), a2 + hstep, voffA);
            PG8_WAIT_V(8); PG8_WAIT_L(0); PG8_BAR; PG8_MMA(0, 0, At, B0); PG8_MMA(0, 1, At, B1); PG8_BAR; PG8_SCHED;
            PG8_LDA(At, 1, 1); PG8_STAGE(PG8_SB(1, 0), b3, voffB); PG8_STAGE(PG8_SB(1, 1), b3 + hstep, voffB); PG8_STAGE(PG8_SA(1, 0), a3, voffA);
            PG8_WAIT_V(8); PG8_WAIT_L(0); PG8_BAR; PG8_MMA(1, 0, At, B0); PG8_MMA(1, 1, At, B1); PG8_BAR; PG8_SCHED;
            } else {
            PG8_LDB(B0, 0, 0); PG8_SCHED; PG8_LDA(At, 0, 0); PG8_STAGE(PG8_SA(1, 1), a1 + hstep, voffA);
            PG8_WAIT_L(8); PG8_BAR; PG8_WAIT_L(0); PG8_MMA(0, 0, At, B0); PG8_BAR; PG8_SCHED;
            PG8_LDB(B1, 0, 1); PG8_STAGE(PG8_SB(0, 0), b2, voffB);
            PG8_BAR; PG8_WAIT_L(0); PG8_MMA(0, 1, At, B1); PG8_BAR;
            PG8_LDA(At, 0, 1); PG8_STAGE(PG8_SA(0, 0), a2, voffA);
            PG8_BAR; PG8_WAIT_L(0); PG8_MMA(1, 0, At, B0); PG8_BAR; PG8_SCHED;
            PG8_STAGE(PG8_SB(0, 1), b2 + hstep, voffB);
            PG8_WAIT_V(6); PG8_BAR; PG8_MMA(1, 1, At, B1); PG8_BAR;
            PG8_LDB(B0, 1, 0); PG8_SCHED; PG8_LDA(At, 1, 0); PG8_STAGE(PG8_SA(0, 1), a2 + hstep, voffA);
            PG8_WAIT_L(8); PG8_BAR; PG8_WAIT_L(0); PG8_MMA(0, 0, At, B0); PG8_BAR; PG8_SCHED;
            PG8_LDB(B1, 1, 1); PG8_STAGE(PG8_SB(1, 0), b3, voffB);
            PG8_BAR; PG8_WAIT_L(0); PG8_MMA(0, 1, At, B1); PG8_BAR;
            PG8_LDA(At, 1, 1); PG8_STAGE(PG8_SA(1, 0), a3, voffA);
            PG8_BAR; PG8_WAIT_L(0); PG8_MMA(1, 0, At, B0); PG8_BAR; PG8_SCHED;
            PG8_STAGE(PG8_SB(1, 1), b3 + hstep, voffB);
            PG8_WAIT_V(6); PG8_BAR; PG8_MMA(1, 1, At, B1); PG8_BAR;
            }
        }
        if constexpr (ALIGN_EPI) { if (wr == 0) PG8_BAR; }
        if constexpr (!Epi::AFTER_DRAIN) { E(acc, cur, wr, wc, fr, fq); S.done(cur); }
        if (!has_next) break;
#pragma unroll
        for (int a = 0; a < 2; ++a)
#pragma unroll
            for (int b = 0; b < 2; ++b)
#pragma unroll
                for (int m = 0; m < 4; ++m)
#pragma unroll
                    for (int n = 0; n < 2; ++n) acc[a][b][m][n] = (f32x4){0.f, 0.f, 0.f, 0.f};
        cur = nxt; cA = nA; cB = nB; ++ui;
        if constexpr (ALIGN_EPI) { if (wr == 1) PG8_BAR; }
    }
    PG8_WAIT_V(0);
    if constexpr (!ALIGN_EPI) { if (wr == 0) PG8_BAR; }
    PG8_BAR;
    if constexpr (Epi::AFTER_DRAIN) { E.fused(acc, cur, wr, wc, fr, fq, lds, wid, lane); S.done(cur); }
#undef PG8_SA
#undef PG8_SB
#undef PG8_STAGE
#undef PG8_LDA
#undef PG8_LDB
#undef PG8_MMA
#undef PG8_WAIT_V
#undef PG8_WAIT_L
#undef PG8_BAR
#undef PG8_SCHED
}
}

#define GAS __attribute__((address_space(1)))
#define LAS __attribute__((address_space(3)))
typedef unsigned short bf16;
typedef float f32x4 __attribute__((ext_vector_type(4)));
typedef short bf16x8 __attribute__((ext_vector_type(8)));
typedef unsigned u32x4 __attribute__((ext_vector_type(4)));
typedef unsigned u32x2 __attribute__((ext_vector_type(2)));

constexpr int DM = 1024, SEQ = 8192, MP = 16384, MS = 128, MV = MP + MS, MT = 16640;
constexpr int NABP = 3584, NABV = 3360, FF = 4096;
constexpr int C_V = 1024, C_O = 1536, C_I = 2048, C_QN = 2056, C_KV = 2568, C_WIN = 3080, C_GN = 3336;
constexpr int NPOOL = 2560;
constexpr float EPSN = 1e-6f;

constexpr size_t O_YP = 0, O_YS = O_YP + 16777216, O_PCONV = O_YS + 131072, O_PC = O_PCONV + 12288, O_PN = O_PC + 262144, O_PM = O_PN + 2048,
                 O_PKV = O_PM + 16, O_PWIN = O_PKV + 16777216, O_SCONV = O_PWIN + 524288, O_SC = O_SCONV + 196608, O_SN = O_SC + 4194304,
                 O_SM = O_SN + 32768, O_SKV = O_SM + 256, O_SWIN = O_SKV + 131072, O_SGV = O_SWIN + 8388608, O_END = O_SGV + 262144;

constexpr size_t MiB = 1u << 20;
constexpr size_t WS_CTL = 0, CTL_ZERO_BYTES = 1 * MiB;
constexpr size_t WS_MOD = 1 * MiB;
constexpr size_t WS_PEC = 6 * MiB;
constexpr size_t WS_WABIN = 8 * MiB;
constexpr size_t WS_WABOUT = 24 * MiB;
constexpr size_t WS_WCLIN = 28 * MiB;
constexpr size_t WS_WCLOUT = 36 * MiB;
constexpr size_t WS_WF1 = 40 * MiB;
constexpr size_t WS_WF2 = 72 * MiB;
constexpr size_t WS_WPHI = 104 * MiB;
constexpr size_t WS_X = 112 * MiB;
constexpr size_t WS_H = 180 * MiB;
constexpr size_t WS_Z = 216 * MiB;
constexpr size_t WS_MIX = 332 * MiB;
constexpr size_t WS_ACT = 368 * MiB;
constexpr size_t WS_GATE = 500 * MiB;
constexpr size_t WS_QK = 504 * MiB;
constexpr size_t WS_G = 540 * MiB;
constexpr size_t WS_CST = 608 * MiB;
constexpr size_t WS_NU = 672 * MiB;
constexpr size_t WS_NST = 673 * MiB;
constexpr size_t WS_CHK = 674 * MiB;
constexpr size_t WS_MST = 675 * MiB;
constexpr size_t WS_KC = 676 * MiB;
constexpr size_t WS_KCS = 680 * MiB;
constexpr size_t WS_A01P = 716 * MiB;
constexpr size_t WS_A01S = 720 * MiB;
constexpr size_t WS_END = 800 * MiB;

constexpr int LDS_BYTES = 163840 - 2048;
constexpr int MISC_OFF = LDS_BYTES - 256;
constexpr int NWAVES = 8, NTHR = 512;

template <class T> __device__ __forceinline__ T* launder(T* p) { asm volatile("" : "+s"(p)); return p; }
__device__ __forceinline__ float bf2f(unsigned h) { return __uint_as_float(h << 16); }
__device__ __forceinline__ unsigned f2bf(float f) { unsigned u = __float_as_uint(f); return (u + 0x7fffu + ((u >> 16) & 1u)) >> 16; }
__device__ __forceinline__ unsigned pk2(float lo, float hi) { return f2bf(lo) | (f2bf(hi) << 16); }
__device__ __forceinline__ float wave_sum(float v) {
#pragma unroll
    for (int o = 1; o < 64; o <<= 1) v += __shfl_xor(v, o);
    return v;
}
__device__ __forceinline__ float wave_max(float v) {
#pragma unroll
    for (int o = 1; o < 64; o <<= 1) v = fmaxf(v, __shfl_xor(v, o));
    return v;
}
__device__ __forceinline__ float sigmoidf_(float x) { return 1.f / (1.f + __expf(-x)); }
__device__ __forceinline__ float siluf_(float x) { return x / (1.f + __expf(-x)); }
__device__ __forceinline__ float logsigmoidf_(float x) { return fminf(x, 0.f) - log1pf(__expf(-fabsf(x))); }
__device__ __forceinline__ float gelu_tanh(float x) { const float u = 1.5957691216f * (x + 0.044715f * x * x * x); return x / (1.f + __expf(-u)); }
__device__ __forceinline__ int mbidx(int row) { return row < MP ? (row >> 13) : 2 + (((row - MP) >> 2) > 31 ? 31 : ((row - MP) >> 2)); }
__device__ __forceinline__ void unpack8(const u32x4 w, float (&o)[8]) {
    o[0] = bf2f(w.x & 0xffffu); o[1] = bf2f(w.x >> 16); o[2] = bf2f(w.y & 0xffffu); o[3] = bf2f(w.y >> 16);
    o[4] = bf2f(w.z & 0xffffu); o[5] = bf2f(w.z >> 16); o[6] = bf2f(w.w & 0xffffu); o[7] = bf2f(w.w >> 16);
}

#define XB_TMO      128
#define XB_XCNT(j)  (256  + 64 * (j))
#define XB_XSUB(j)  (1280 + 64 * (j))
#define XB_XGEN(j)  (2304 + 64 * (j))
#define XB_TOP      3328
#define XB_TOPGEN   3392
#define XCD_BAR_WORDS 3456
#define XB_SPIN_CAP (1u << 18)
__device__ __forceinline__ unsigned xb_ld(unsigned* p)              { return __hip_atomic_load(p, __ATOMIC_RELAXED, __HIP_MEMORY_SCOPE_AGENT); }
__device__ __forceinline__ unsigned xb_add(unsigned* p, unsigned v) { return __hip_atomic_fetch_add(p, v, __ATOMIC_RELAXED, __HIP_MEMORY_SCOPE_AGENT); }
__device__ __forceinline__ unsigned xb_xcc_id() { return (unsigned)__builtin_amdgcn_s_getreg((3 << 11) | 20) & 0xFu; }
#define XB_SPIN(cond, bar) do { unsigned _sp = 0; while (cond) { __builtin_amdgcn_s_sleep(1); \
    if ((++_sp & 255u) == 0u) { if (xb_ld(&(bar)[XB_TMO])) break; if (_sp > XB_SPIN_CAP) { atomicAdd(&(bar)[XB_TMO], 1u); break; } } } } while (0)
struct XcdBarrier { unsigned* bar; unsigned x; volatile LAS unsigned* st; };
__device__ __forceinline__ XcdBarrier xcd_barrier_post(unsigned* bar, volatile LAS unsigned* st) {
    XcdBarrier b; b.bar = bar; b.x = xb_xcc_id(); b.st = st;
    if (threadIdx.x == 0) (void)xb_add(&bar[XB_XCNT(b.x)], 1u);
    return b;
}
__device__ __forceinline__ void xcd_barrier_complete(unsigned* bar, unsigned x, unsigned& nloc, unsigned& nx) {
    const unsigned G = gridDim.x * gridDim.y * gridDim.z;
    unsigned sum, cnt, mine, sp = 0u;
    for (;;) {
        sum = 0u; cnt = 0u; mine = 0u;
#pragma unroll
        for (unsigned j = 0; j < 16; ++j) { const unsigned c = xb_ld(&bar[XB_XCNT(j)]); sum += c; cnt += (c > 0u) ? 1u : 0u; mine = (j == x) ? c : mine; }
        if (sum == G) break;
        __builtin_amdgcn_s_sleep(1);
        if ((++sp & 255u) == 0u) { if (xb_ld(&bar[XB_TMO])) break; if (sp > XB_SPIN_CAP) { atomicAdd(&bar[XB_TMO], 1u); break; } }
    }
    nloc = mine > 0u ? mine : 1u; nx = cnt > 0u ? cnt : 1u;
}
__device__ __forceinline__ void xcd_barrier(const XcdBarrier& b) {
    asm volatile("s_waitcnt vmcnt(0)" ::: "memory");
    __syncthreads();
    if (threadIdx.x == 0) {
        unsigned* bar = b.bar;
        __builtin_amdgcn_s_waitcnt(0);
        unsigned nloc = b.st[0], nx = b.st[1];
        if (nloc == 0u) { xcd_barrier_complete(bar, b.x, nloc, nx); b.st[0] = nloc; b.st[1] = nx; }
        const unsigned old = xb_add(&bar[XB_XSUB(b.x)], 1u);
        const unsigned gen = old / nloc;
        if (old + 1u == (gen + 1u) * nloc) {
            __builtin_amdgcn_fence(__ATOMIC_RELEASE, "agent");
            asm volatile("s_waitcnt vmcnt(0)" ::: "memory");
            const unsigned og = xb_add(&bar[XB_TOP], 1u);
            const unsigned tg = og / nx;
            if (og + 1u == (tg + 1u) * nx) xb_add(&bar[XB_TOPGEN], 1u);
            else XB_SPIN(xb_ld(&bar[XB_TOPGEN]) == tg, bar);
            __builtin_amdgcn_fence(__ATOMIC_ACQUIRE, "agent");
            xb_add(&bar[XB_XGEN(b.x)], 1u);
            asm volatile("s_waitcnt vmcnt(0)" ::: "memory");
        } else {
            XB_SPIN(xb_ld(&bar[XB_XGEN(b.x)]) == gen, bar);
            __builtin_amdgcn_fence(__ATOMIC_ACQUIRE, "agent");
            asm volatile("s_waitcnt vmcnt(0)" ::: "memory");
        }
    }
    __syncthreads();
}

struct Params {
    const float *x_prompt, *x_sample, *c_prompt, *c_sample, *st_conv, *st_C, *st_n, *st_m, *cache, *st_win;
    const int* page_table;
    const float *ada_w, *ada_b, *norm_g, *ab_w_in, *ab_b_in, *ml_conv_w, *ml_conv_b, *ml_f_bias, *ml_out_g, *phi_pe, *phi_w1, *phi_b1, *phi_w2, *phi_b2,
                *ab_w_out, *cl_w_in, *cl_b_in, *cl_v_g, *cl_ws, *cl_bs, *cl_w_out, *ffn_w1, *ffn_w2, *final_g;
    float* out; unsigned char* ws;
    int ph_lo, ph_hi, li, pad;
};

namespace pg8 {
__device__ __forceinline__ u32x4 pack8(const f32x4 a, const f32x4 b) { u32x4 w; w.x = cvt_pk_bf16(a[0], a[1]); w.y = cvt_pk_bf16(a[2], a[3]); w.z = cvt_pk_bf16(b[0], b[1]); w.w = cvt_pk_bf16(b[2], b[3]); return w; }
struct EpiAbIn {
    static constexpr bool PERM = true, AFTER_DRAIN = false;
    bf16_t* Z; const float* bias; float* gate; float* out; int j;
    __device__ __forceinline__ void operator()(const f32x4 (&acc)[2][2][4][2], const Unit& u, int wr, int wc, int fr, int fq) const {
#pragma unroll
        for (int bj = 0; bj < 2; ++bj) {
            const int col = u.pn * BM + bj * HALF + wc * 32 + 8 * fq;
            if (col >= NABV) continue;
            const f32x4 b0 = *(const f32x4*)(bias + col), b1 = *(const f32x4*)(bias + col + 4);
#pragma unroll
            for (int ai = 0; ai < 2; ++ai)
#pragma unroll
                for (int m = 0; m < 4; ++m) {
                    const int row = u.pm * BM + ai * HALF + wr * 64 + m * 16 + fr;
                    if (row >= MV) continue;
                    const f32x4 v0 = acc[ai][bj][m][0] + b0, v1 = acc[ai][bj][m][1] + b1;
                    *(u32x4*)(Z + (size_t)row * NABP + col) = pack8(v0, v1);
                    float* dst = nullptr;
                    const bool isp = row < MP; const int b = isp ? (row >> 13) : ((row - MP) >> 2), t = isp ? (row & 8191) : ((row - MP) & 3);
                    if (col >= C_I && col < C_I + 8) dst = gate + (size_t)row * 8;
                    else if (col < 1024) { if (isp) { if (t >= SEQ - 3) dst = out + O_PCONV + ((size_t)(j * 2 + b) * 3 + (t - (SEQ - 3))) * 1024 + col; }
                                           else if (t >= 1) dst = out + O_SCONV + ((size_t)(j * 32 + b) * 3 + (t - 1)) * 1024 + col; }
                    else if (col >= C_KV && col < C_WIN) { dst = isp ? out + O_PKV + ((size_t)(j * 2 + b) * SEQ + t) * 512 + (col - C_KV) : out + O_SKV + ((size_t)(j * 32 + b) * 4 + t) * 512 + (col - C_KV); }
                    else if (col >= C_WIN && col < C_GN) { if (isp) { if (t >= SEQ - 512) dst = out + O_PWIN + ((size_t)(j * 2 + b) * 512 + (t - (SEQ - 512))) * 256 + (col - C_WIN); }
                                                           else dst = out + O_SWIN + ((size_t)(j * 32 + b) * 512 + 508 + t) * 256 + (col - C_WIN); }
                    if (dst) { *(f32x4*)dst = v0; *(f32x4*)(dst + 4) = v1; }
                }
        }
    }
};
struct EpiResid {
    static constexpr bool PERM = false, AFTER_DRAIN = false;
    float* X; const float* mod;
    __device__ __forceinline__ void operator()(const f32x4 (&acc)[2][2][4][2], const Unit& u, int wr, int wc, int fr, int fq) const {
#pragma unroll
        for (int ai = 0; ai < 2; ++ai)
#pragma unroll
            for (int m = 0; m < 4; ++m) {
                const int row = u.pm * BM + ai * HALF + wr * 64 + m * 16 + fr;
                if (row >= MV) continue;
                const float* g = mod + (size_t)mbidx(row) * 6144; float* xr = X + (size_t)row * DM;
#pragma unroll
                for (int bj = 0; bj < 2; ++bj)
#pragma unroll
                    for (int n = 0; n < 2; ++n) { const int col = u.pn * BM + bj * HALF + wc * 32 + 16 * n + 4 * fq;
                        const f32x4 gv = *(const f32x4*)(g + col); f32x4 xv = *(const f32x4*)(xr + col); xv = xv + gv * acc[ai][bj][m][n]; *(f32x4*)(xr + col) = xv; }
            }
    }
};
template <int ACT> struct EpiAct {
    static constexpr bool PERM = true, AFTER_DRAIN = false;
    bf16_t* O; int ldc; const float* bias;
    __device__ __forceinline__ void operator()(const f32x4 (&acc)[2][2][4][2], const Unit& u, int wr, int wc, int fr, int fq) const {
#pragma unroll
        for (int bj = 0; bj < 2; ++bj) {
            const int col = u.pn * BM + bj * HALF + wc * 32 + 8 * fq;
            f32x4 b0 = (f32x4){0.f, 0.f, 0.f, 0.f}, b1 = b0;
            if (ACT == 1) { b0 = *(const f32x4*)(bias + col); b1 = *(const f32x4*)(bias + col + 4); }
#pragma unroll
            for (int ai = 0; ai < 2; ++ai)
#pragma unroll
                for (int m = 0; m < 4; ++m) {
                    const int row = u.pm * BM + ai * HALF + wr * 64 + m * 16 + fr;
                    f32x4 v0 = acc[ai][bj][m][0] + b0, v1 = acc[ai][bj][m][1] + b1;
#pragma unroll
                    for (int e = 0; e < 4; ++e) {
                        if (ACT == 0) { const float a = fmaxf(v0[e], 0.f), c = fmaxf(v1[e], 0.f); v0[e] = a * a; v1[e] = c * c; }
                        else { v0[e] = gelu_tanh(v0[e]); v1[e] = gelu_tanh(v1[e]); }
                    }
                    *(u32x4*)(O + (size_t)row * ldc + col) = pack8(v0, v1);
                }
        }
    }
};
}

template <class LA, class LB, class EP>
__device__ __forceinline__ void tile_gemm_64x128(unsigned char* lds, int tid, int K, const LA& la, const LB& lb, const EP& epi) {
    const int lane = tid & 63, wid = tid >> 6, wm = wid >> 2, wn = wid & 3, fr = lane & 15, fq = lane >> 4;
    bf16* As = (bf16*)lds; bf16* Bs = (bf16*)(lds + 64 * 144);
    const int lr = tid >> 3, lk = (tid & 7) * 8;
    f32x4 acc[2][2];
#pragma unroll
    for (int a = 0; a < 2; ++a)
#pragma unroll
        for (int b = 0; b < 2; ++b) acc[a][b] = (f32x4){0.f, 0.f, 0.f, 0.f};
    bf16x8 ra = la(lr, lk), rb0 = lb(lr, lk), rb1 = lb(lr + 64, lk);
    for (int k0 = 0; k0 < K; k0 += 64) {
        __syncthreads();
        *(bf16x8*)(As + lr * 72 + lk) = ra; *(bf16x8*)(Bs + lr * 72 + lk) = rb0; *(bf16x8*)(Bs + (lr + 64) * 72 + lk) = rb1;
        __syncthreads();
        if (k0 + 64 < K) { ra = la(lr, k0 + 64 + lk); rb0 = lb(lr, k0 + 64 + lk); rb1 = lb(lr + 64, k0 + 64 + lk); }
#pragma unroll
        for (int ks = 0; ks < 2; ++ks) {
            bf16x8 af[2], bfv[2];
#pragma unroll
            for (int i = 0; i < 2; ++i) { af[i] = *(const bf16x8*)(As + (wm * 32 + i * 16 + fr) * 72 + ks * 32 + fq * 8); bfv[i] = *(const bf16x8*)(Bs + (wn * 32 + i * 16 + fr) * 72 + ks * 32 + fq * 8); }
#pragma unroll
            for (int mi = 0; mi < 2; ++mi)
#pragma unroll
                for (int ni = 0; ni < 2; ++ni) acc[mi][ni] = __builtin_amdgcn_mfma_f32_16x16x32_bf16(bfv[ni], af[mi], acc[mi][ni], 0, 0, 0);
        }
    }
#pragma unroll
    for (int mi = 0; mi < 2; ++mi)
#pragma unroll
        for (int ni = 0; ni < 2; ++ni) epi(wm * 32 + mi * 16 + fr, wn * 32 + ni * 16 + 4 * fq, acc[mi][ni]);
    __syncthreads();
}

struct Ctx { unsigned char* lds; int tid, lane, wave, bid, G; };
__device__ __forceinline__ Ctx relaunder(const Ctx& C0) {
    Ctx C = C0; asm volatile("" : "+v"(C.tid)); asm volatile("" : "+s"(C.lds)); asm volatile("" : "+s"(C.bid)); C.lane = C.tid & 63; C.wave = __builtin_amdgcn_readfirstlane(C.tid >> 6); return C; }

__device__ __forceinline__ void transpose_item(const float* W, int K, int N, bf16* WT, int item, float* scr, int lane) {
    const int nblk = N / 32, kb = item / nblk, nb = item % nblk, k0 = 64 * kb, n0 = 32 * nb;
#pragma unroll 8
    for (int i = 0; i < 32; ++i) { const int kk = 2 * i + (lane >> 5); scr[kk * 33 + (lane & 31)] = W[(size_t)(k0 + kk) * N + n0 + (lane & 31)]; }
    asm volatile("s_waitcnt lgkmcnt(0)" ::: "memory");
    const int c = lane & 7;
#pragma unroll
    for (int j = 0; j < 4; ++j) { const int n = (lane >> 3) + 8 * j; const float* s = scr + (8 * c) * 33 + n;
        u32x4 o; o.x = pk2(s[0 * 33], s[1 * 33]); o.y = pk2(s[2 * 33], s[3 * 33]); o.z = pk2(s[4 * 33], s[5 * 33]); o.w = pk2(s[6 * 33], s[7 * 33]);
        *(u32x4*)(WT + (size_t)(n0 + n) * K + k0 + 8 * c) = o; }
    asm volatile("s_waitcnt lgkmcnt(0)" ::: "memory");
}

__device__ __forceinline__ void job_transposes(const Params& P, const Ctx& C0) { unsigned char* const wsb = launder(P.ws); const Ctx C = relaunder(C0);
    float* scr = (float*)(C.lds + C.wave * 8448);
    const int gw = C.bid * NWAVES + C.wave, NGW = C.G * NWAVES;
    constexpr int I_ABIN = 16 * 105, I_SQ = 16 * 32, I_CLIN = 16 * 64, I_F1 = 16 * 128, I_F2 = 64 * 32, I_PHI = 16 * 2;
    constexpr int NIT = 2 * I_ABIN + 2 * I_SQ + 2 * I_CLIN + 2 * I_SQ + 4 * I_F1 + 4 * I_F2 + 8 * I_PHI;
    unsigned char* ws = wsb;
    for (int it = gw; it < NIT; it += NGW) {
        int r = it;
        if (r < 2 * I_ABIN) { const int j = r / I_ABIN; transpose_item(P.ab_w_in + (size_t)j * DM * NABV, DM, NABV, (bf16*)(ws + WS_WABIN) + (size_t)j * NABP * DM, r % I_ABIN, scr, C.lane); continue; } r -= 2 * I_ABIN;
        if (r < 2 * I_SQ) { const int j = r / I_SQ; transpose_item(P.ab_w_out + (size_t)j * DM * DM, DM, DM, (bf16*)(ws + WS_WABOUT) + (size_t)j * DM * DM, r % I_SQ, scr, C.lane); continue; } r -= 2 * I_SQ;
        if (r < 2 * I_CLIN) { const int j = r / I_CLIN; transpose_item(P.cl_w_in + (size_t)j * DM * 2048, DM, 2048, (bf16*)(ws + WS_WCLIN) + (size_t)j * 2048 * DM, r % I_CLIN, scr, C.lane); continue; } r -= 2 * I_CLIN;
        if (r < 2 * I_SQ) { const int j = r / I_SQ; transpose_item(P.cl_w_out + (size_t)j * DM * DM, DM, DM, (bf16*)(ws + WS_WCLOUT) + (size_t)j * DM * DM, r % I_SQ, scr, C.lane); continue; } r -= 2 * I_SQ;
        if (r < 4 * I_F1) { const int l = r / I_F1; transpose_item(P.ffn_w1 + (size_t)l * DM * FF, DM, FF, (bf16*)(ws + WS_WF1) + (size_t)l * FF * DM, r % I_F1, scr, C.lane); continue; } r -= 4 * I_F1;
        if (r < 4 * I_F2) { const int l = r / I_F2; transpose_item(P.ffn_w2 + (size_t)l * FF * DM, FF, DM, (bf16*)(ws + WS_WF2) + (size_t)l * DM * FF, r % I_F2, scr, C.lane); continue; } r -= 4 * I_F2;
        { const int q = r / I_PHI;
          transpose_item(P.phi_w1 + ((size_t)(q >> 1) * 2048 + (size_t)(q & 1) * 1024) * 64, 1024, 64, (bf16*)(ws + WS_WPHI) + ((size_t)(q >> 1) * 128 + (size_t)(q & 1) * 64) * 1024, r % I_PHI, scr, C.lane); }
    }
    const int gt = C.bid * NTHR + C.tid, NGT = C.G * NTHR;
    for (int i = gt; i < 2 * (NABP - NABV) * DM / 8; i += NGT) { const int j = i / ((NABP - NABV) * DM / 8), o = i % ((NABP - NABV) * DM / 8);
        *(u32x4*)((bf16*)(ws + WS_WABIN) + ((size_t)j * NABP + NABV) * DM + (size_t)o * 8) = (u32x4){0u, 0u, 0u, 0u}; }
}

__device__ __forceinline__ void job_copy_x(const Params& P, const Ctx& C0) { unsigned char* const wsb = launder(P.ws); const Ctx C = relaunder(C0);
    float* X = (float*)(wsb + WS_X);
    const int gw = C.bid * NWAVES + C.wave, NGW = C.G * NWAVES;
    for (int r = gw; r < MT; r += NGW) {
        f32x4* dst = (f32x4*)(X + (size_t)r * DM) + C.lane;
        if (r < MV) { const f32x4* src = (const f32x4*)(r < MP ? P.x_prompt + (size_t)r * DM : P.x_sample + (size_t)(r - MP) * DM) + C.lane;
#pragma unroll
            for (int i = 0; i < 4; ++i) dst[64 * i] = src[64 * i]; }
        else {
#pragma unroll
            for (int i = 0; i < 4; ++i) dst[64 * i] = (f32x4){0.f, 0.f, 0.f, 0.f}; }
    }
    const int gt = C.bid * NTHR + C.tid, NGT = C.G * NTHR;
    for (int i = gt; i < 64 * 508 * 64; i += NGT) { const int jb = i / (508 * 64), o = i % (508 * 64);
        ((f32x4*)(P.out + O_SWIN + (size_t)jb * 512 * 256))[o] = ((const f32x4*)(P.st_win + (size_t)jb * 512 * 256 + 4 * 256))[o]; }
    if (gw < 4) { const float* pe = P.phi_pe + (size_t)gw * 2048; const float* w1 = P.phi_w1 + (size_t)gw * 2048 * 64; float a = P.phi_b1[gw * 64 + C.lane];
        for (int kk = 0; kk < 2048; ++kk) a += pe[kk] * w1[(size_t)kk * 64 + C.lane];
        ((float*)(wsb + WS_PEC))[gw * 64 + C.lane] = a; }
}

__device__ __forceinline__ void job_adaln(const Params& P, const Ctx& C0) { unsigned char* const wsb = launder(P.ws); const Ctx C = relaunder(C0);
    float* SC = (float*)C.lds;
    __syncthreads();
    for (int i = C.tid; i < 34 * 1024; i += NTHR) { const int mb = i >> 10, k = i & 1023; const float c = mb < 2 ? P.c_prompt[mb * 1024 + k] : P.c_sample[(mb - 2) * 1024 + k]; SC[k * 36 + mb] = siluf_(c); }
    __syncthreads();
    float* MOD = (float*)(wsb + WS_MOD);
    const int gw = C.bid * NWAVES + C.wave, NGW = C.G * NWAVES, ks = C.lane >> 4, cl = C.lane & 15;
    for (int u = gw; u < 4 * 384; u += NGW) {
        const int l = u / 384, n = (u % 384) * 16 + cl;
        const float* w = P.ada_w + (size_t)l * DM * 6144 + n;
        float acc[34];
#pragma unroll
        for (int i = 0; i < 34; ++i) acc[i] = 0.f;
        for (int k = ks; k < 1024; k += 4) {
            const float wv = w[(size_t)k * 6144];
            const f32x4* s4 = (const f32x4*)(SC + k * 36);
#pragma unroll
            for (int q = 0; q < 8; ++q) { const f32x4 s = s4[q]; acc[4 * q] += s[0] * wv; acc[4 * q + 1] += s[1] * wv; acc[4 * q + 2] += s[2] * wv; acc[4 * q + 3] += s[3] * wv; }
            { const f32x4 s = s4[8]; acc[32] += s[0] * wv; acc[33] += s[1] * wv; }
        }
#pragma unroll
        for (int i = 0; i < 34; ++i) { float a = acc[i]; a += __shfl_xor(a, 16); a += __shfl_xor(a, 32); acc[i] = a; }
        if (ks == 0) { const float bb = P.ada_b[l * 6144 + n];
#pragma unroll
            for (int i = 0; i < 34; ++i) MOD[((size_t)l * 34 + i) * 6144 + n] = acc[i] + bb; }
    }
    __syncthreads();
}

template <bool FINAL>
__device__ __forceinline__ void job_norm(const Params& P, const Ctx& C0, int l, int idx) { unsigned char* const wsb = launder(P.ws); const Ctx C = relaunder(C0);
    const float* X = (const float*)(wsb + WS_X); bf16* H = (bf16*)(wsb + WS_H); const float* MOD = (const float*)(wsb + WS_MOD);
    const int gw = C.bid * NWAVES + C.wave, NGW = C.G * NWAVES;
    const float* g = FINAL ? P.final_g : P.norm_g + (size_t)(l * 2 + idx) * DM;
    for (int r = gw; r < (FINAL ? MV : MT); r += NGW) {
        if (!FINAL && r >= MV) { u32x2* o = (u32x2*)(H + (size_t)r * DM) + C.lane;
#pragma unroll
            for (int i = 0; i < 4; ++i) o[64 * i] = (u32x2){0u, 0u};
            continue; }
        const f32x4* xr = (const f32x4*)(X + (size_t)r * DM) + C.lane;
        f32x4 v[4]; float s = 0.f;
#pragma unroll
        for (int i = 0; i < 4; ++i) { v[i] = xr[64 * i]; s += (v[i][0] * v[i][0] + v[i][1] * v[i][1]) + (v[i][2] * v[i][2] + v[i][3] * v[i][3]); }
        const float rstd = rsqrtf(wave_sum(s) * (1.f / DM) + EPSN);
        if (FINAL) { f32x4* o = (f32x4*)(P.out + (r < MP ? O_YP + (size_t)r * DM : O_YS + (size_t)(r - MP) * DM)) + C.lane;
#pragma unroll
            for (int i = 0; i < 4; ++i) { const f32x4 gv = ((const f32x4*)g)[C.lane + 64 * i]; o[64 * i] = v[i] * rstd * gv; } }
        else { const float* mr = MOD + ((size_t)l * 34 + mbidx(r)) * 6144; const f32x4* sh = (const f32x4*)(mr + (idx ? 3 : 0) * DM) + C.lane; const f32x4* sc = (const f32x4*)(mr + (idx ? 4 : 1) * DM) + C.lane;
            u32x2* o = (u32x2*)(H + (size_t)r * DM) + C.lane;
#pragma unroll
            for (int i = 0; i < 4; ++i) { const f32x4 gv = ((const f32x4*)g)[C.lane + 64 * i]; const f32x4 y = v[i] * rstd * gv * (sc[64 * i] + 1.f) + sh[64 * i]; o[64 * i] = (u32x2){pk2(y[0], y[1]), pk2(y[2], y[3])}; } }
    }
}

template <bool SAMPLE>
__device__ __forceinline__ void job_compress1(const Params& P, const Ctx& C0, int j) { unsigned char* const wsb = launder(P.ws); const Ctx C = relaunder(C0);
    const int NB = SAMPLE ? 32 : 2, ntile = 2 * NB * 512 * 2 / 64;
    const bf16* Z = (const bf16*)(wsb + WS_Z);
    float* A01 = SAMPLE ? (float*)(wsb + WS_A01S) + (size_t)j * 65536 * 128 : (float*)(wsb + WS_A01P);
    for (int tl = C.bid; tl < ntile; tl += C.G) {
        const int row0 = tl * 64, type = row0 / (NB * 1024);
        const bf16* W = (const bf16*)(wsb + WS_WPHI) + (size_t)(j * 2 + type) * 128 * 1024;
        auto la = [&](int r, int k) -> bf16x8 {
            const int row = row0 + r, g = row & 1, i = (row >> 1) & 511, b = (row >> 10) % NB, p = k >> 6, d = k & 63, pos = i * 16 + p;
            if (SAMPLE) { const int page = P.page_table[b * 64 + (pos >> 7)];
                const float* src = P.cache + ((((size_t)j * NPOOL + page) * 128 + (pos & 127)) * 4 + type) * 128 + g * 64 + d;
                const f32x4 a = *(const f32x4*)src, c = *(const f32x4*)(src + 4);
                u32x4 w; w.x = pk2(a[0], a[1]); w.y = pk2(a[2], a[3]); w.z = pk2(c[0], c[1]); w.w = pk2(c[2], c[3]); return __builtin_bit_cast(bf16x8, w); }
            else return *(const bf16x8*)(Z + (size_t)(b * SEQ + pos) * NABP + C_KV + type * 128 + g * 64 + d);
        };
        auto lb = [&](int n, int k) -> bf16x8 { return *(const bf16x8*)(W + (size_t)n * 1024 + k); };
        auto ep = [&](int r, int c, f32x4 v) { *(f32x4*)(A01 + (size_t)(row0 + r) * 128 + c) = v; };
        tile_gemm_64x128(C.lds, C.tid, 1024, la, lb, ep);
    }
}
template <bool SAMPLE>
__device__ __forceinline__ void job_compress2(const Params& P, const Ctx& C0, int j) { unsigned char* const wsb = launder(P.ws); const Ctx C = relaunder(C0);
    const int NB = SAMPLE ? 32 : 2, nrow = 2 * NB * 511 * 2;
    const float* A01 = SAMPLE ? (const float*)(wsb + WS_A01S) + (size_t)j * 65536 * 128 : (const float*)(wsb + WS_A01P);
    float* KC = SAMPLE ? (float*)(wsb + WS_KCS) + (size_t)j * 2 * 32 * 512 * 128 : (float*)(wsb + WS_KC);
    const float* PEC = (const float*)(wsb + WS_PEC);
    const int gw = C.bid * NWAVES + C.wave, NGW = C.G * NWAVES;
    for (int u = gw; u < nrow; u += NGW) {
        const int g = u & 1, n = (u >> 1) % 511, tb = (u >> 1) / 511, type = tb / NB, b = tb % NB;
        const size_t r0 = ((size_t)(type * NB + b) * 512 + n) * 2 + g;
        const float pre = PEC[(j * 2 + type) * 64 + C.lane] + A01[r0 * 128 + C.lane] + A01[(r0 + 2) * 128 + 64 + C.lane];
        const float hid = gelu_tanh(pre);
        const float* w2 = P.phi_w2 + (size_t)(j * 2 + type) * 4096;
        float a = P.phi_b2[(j * 2 + type) * 64 + C.lane];
#pragma unroll 8
        for (int hc = 0; hc < 64; ++hc) a += __shfl(hid, hc) * w2[hc * 64 + C.lane];
        KC[r0 * 64 + C.lane] = a;
    }
}

__device__ __forceinline__ void job_mlstm_local(const Params& P, const Ctx& C0, int j) { unsigned char* const wsb = launder(P.ws); const Ctx C = relaunder(C0);
    const bf16* Z = (const bf16*)(wsb + WS_Z); const float* GT = (const float*)(wsb + WS_GATE); bf16* QK = (bf16*)(wsb + WS_QK);
    float* G = (float*)(wsb + WS_G); float* NU = (float*)(wsb + WS_NU); float* CHK = (float*)(wsb + WS_CHK);
    float* kf = (float*)C.lds; float* vf = kf + 64 * 128; float* wts = vf + 64 * 128;
    const int tid = C.tid;
    for (int u = C.bid; u < 1024; u += C.G) {
        const int bh = u >> 7, c = u & 127, b = bh >> 2, h = bh & 3, r0 = b * SEQ + c * 64;
        __syncthreads();
        if (C.wave == 0) {
            const int t = C.lane; const float li = GT[(size_t)(r0 + t) * 8 + h]; const float lf = logsigmoidf_(GT[(size_t)(r0 + t) * 8 + 4 + h] + P.ml_f_bias[j * 4 + h]);
            float bt = lf;
#pragma unroll
            for (int o = 1; o < 64; o <<= 1) { const float y = __shfl_up(bt, o); if (t >= o) bt += y; }
            const float bl = __shfl(bt, 63), gs = bl - bt + li, gm = wave_max(gs);
            wts[t] = __expf(gs - gm);
            if (t == 0) { CHK[u * 4] = bl; CHK[u * 4 + 1] = gm; }
        }
        {
            const int cc = tid & 255, t0 = (tid >> 8) * 32, col = cc < 128 ? h * 128 + cc : 512 + h * 128 + (cc - 128);
            const float* cw = P.ml_conv_w + (size_t)j * 4 * 1024 + col; const float w0 = cw[0], w1 = cw[1024], w2 = cw[2048], w3 = cw[3072], cb = P.ml_conv_b[j * 1024 + col];
            float x0, x1, x2;
            { const int tg = c * 64 + t0; const bf16* zp = Z + (size_t)(r0 + t0) * NABP + col;
              x0 = tg >= 3 ? bf2f(*(zp - 3 * NABP)) : 0.f; x1 = tg >= 2 ? bf2f(*(zp - 2 * NABP)) : 0.f; x2 = tg >= 1 ? bf2f(*(zp - NABP)) : 0.f; }
#pragma unroll 4
            for (int i = 0; i < 32; ++i) { const int t = t0 + i; const float x3 = bf2f(Z[(size_t)(r0 + t) * NABP + col]);
                const float y = cb + w0 * x0 + w1 * x1 + w2 * x2 + w3 * x3; float s = siluf_(y); if (cc >= 128) s *= 0.08838834764831845f;
                const unsigned hb = f2bf(s); QK[(size_t)(r0 + t) * 1024 + col] = (bf16)hb; if (cc >= 128) kf[t * 128 + (cc - 128)] = bf2f(hb);
                x0 = x1; x1 = x2; x2 = x3; }
            for (int i = tid; i < 64 * 128; i += NTHR) { const int t = i >> 7, e = i & 127; vf[i] = bf2f(Z[(size_t)(r0 + t) * NABP + C_V + h * 128 + e]); }
        }
        __syncthreads();
        const int d0 = (tid >> 4) * 4, e0 = (tid & 15) * 8;
        float acc[4][8], nu[4];
#pragma unroll
        for (int a = 0; a < 4; ++a) { nu[a] = 0.f;
#pragma unroll
            for (int e = 0; e < 8; ++e) acc[a][e] = 0.f; }
        for (int s = 0; s < 64; ++s) {
            const float w = wts[s]; const f32x4 k4 = *(const f32x4*)(kf + s * 128 + d0) * w; const f32x4 va = *(const f32x4*)(vf + s * 128 + e0), vb = *(const f32x4*)(vf + s * 128 + e0 + 4);
#pragma unroll
            for (int a = 0; a < 4; ++a) { nu[a] += k4[a];
#pragma unroll
                for (int e = 0; e < 4; ++e) { acc[a][e] += k4[a] * va[e]; acc[a][4 + e] += k4[a] * vb[e]; } }
        }
#pragma unroll
        for (int a = 0; a < 4; ++a) { float* gp = G + ((size_t)u * 128 + d0 + a) * 128 + e0; *(f32x4*)gp = (f32x4){acc[a][0], acc[a][1], acc[a][2], acc[a][3]}; *(f32x4*)(gp + 4) = (f32x4){acc[a][4], acc[a][5], acc[a][6], acc[a][7]};
            if ((tid & 15) == 0) NU[u * 128 + d0 + a] = nu[a]; }
    }
    __syncthreads();
}

__device__ __forceinline__ void job_mlstm_scan(const Params& P, const Ctx& C0, int j) { unsigned char* const wsb = launder(P.ws); const Ctx C = relaunder(C0);
    const float* G = (const float*)(wsb + WS_G); const float* NU = (const float*)(wsb + WS_NU); const float* CHK = (const float*)(wsb + WS_CHK);
    float* CST = (float*)(wsb + WS_CST); float* NST = (float*)(wsb + WS_NST); float* MST = (float*)(wsb + WS_MST);
    float* dec = (float*)C.lds; float* scl = dec + 128; float* blv = scl + 128; float* gmv = blv + 128; float* mfin = gmv + 128;
    for (int u = C.bid; u < 8 * 33; u += C.G) {
        const int bh = u / 33, sl = u % 33, b = bh >> 2, h = bh & 3;
        __syncthreads();
        if (C.tid < 128) { blv[C.tid] = CHK[(bh * 128 + C.tid) * 4]; gmv[C.tid] = CHK[(bh * 128 + C.tid) * 4 + 1]; }
        __syncthreads();
        if (C.tid == 0) { float m = 0.f;
            for (int c = 0; c < 128; ++c) { const float mn = fmaxf(m + blv[c], gmv[c]); dec[c] = __expf(m + blv[c] - mn); scl[c] = __expf(gmv[c] - mn); if (sl == 0) MST[bh * 128 + c] = m; m = mn; }
            mfin[0] = m; if (sl == 0) P.out[O_PM + (j * 2 + b) * 4 + h] = m; }
        __syncthreads();
        if (sl < 32) { const int el = sl * 512 + C.tid; float cv = 0.f;
#pragma unroll 8
            for (int c = 0; c < 128; ++c) { const size_t o = ((size_t)(bh * 128 + c)) * 16384 + el; CST[o] = cv; cv = dec[c] * cv + scl[c] * G[o]; }
            P.out[O_PC + ((size_t)(j * 2 + b) * 4 + h) * 16384 + el] = cv; }
        else if (C.tid < 128) { float nv = 0.f;
            for (int c = 0; c < 128; ++c) { const size_t o = (size_t)(bh * 128 + c) * 128 + C.tid; NST[o] = nv; nv = dec[c] * nv + scl[c] * NU[o]; }
            P.out[O_PN + ((size_t)(j * 2 + b) * 4 + h) * 128 + C.tid] = nv; }
    }
    __syncthreads();
}

__device__ __forceinline__ void job_mlstm_out(const Params& P, const Ctx& C0, int j) { unsigned char* const wsb = launder(P.ws); const Ctx C = relaunder(C0);
    const bf16* Z = (const bf16*)(wsb + WS_Z); const float* GT = (const float*)(wsb + WS_GATE); const bf16* QK = (const bf16*)(wsb + WS_QK);
    const float* CST = (const float*)(wsb + WS_CST); const float* NST = (const float*)(wsb + WS_NST); const float* MST = (const float*)(wsb + WS_MST);
    bf16* MIX = (bf16*)(wsb + WS_MIX);
    bf16* qb = (bf16*)C.lds; bf16* kb = qb + 64 * 128; bf16* vb = kb + 64 * 128; float* Cl = (float*)(C.lds + 49152); float* S = (float*)(C.lds + 49152 + 65536);
    float* misc = (float*)(C.lds + 49152 + 65536 + 16384); float* btv = misc, *mtv = misc + 64, *wiv = misc + 128, *libv = misc + 192, *nvec = misc + 256, *qn = misc + 384;
    const int tid = C.tid;
    for (int u = C.bid; u < 1024; u += C.G) {
        const int bh = u >> 7, c = u & 127, b = bh >> 2, h = bh & 3, r0 = b * SEQ + c * 64;
        __syncthreads();
        if (C.wave == 0) {
            const int t = C.lane; const float li = GT[(size_t)(r0 + t) * 8 + h]; const float lf = logsigmoidf_(GT[(size_t)(r0 + t) * 8 + 4 + h] + P.ml_f_bias[j * 4 + h]);
            float bt = lf;
#pragma unroll
            for (int o = 1; o < 64; o <<= 1) { const float y = __shfl_up(bt, o); if (t >= o) bt += y; }
            float pm = li - bt;
#pragma unroll
            for (int o = 1; o < 64; o <<= 1) { const float y = __shfl_up(pm, o); if (t >= o) pm = fmaxf(pm, y); }
            const float m = MST[u], mt = bt + fmaxf(m, pm);
            btv[t] = bt; mtv[t] = mt; wiv[t] = __expf(m + bt - mt); libv[t] = li - bt;
        }
        for (int i = tid; i < 1024; i += NTHR) { const int t = i >> 4, ch = (i & 15) * 8;
            *(u32x4*)(qb + t * 128 + ch) = *(const u32x4*)(QK + (size_t)(r0 + t) * 1024 + h * 128 + ch);
            *(u32x4*)(kb + t * 128 + ch) = *(const u32x4*)(QK + (size_t)(r0 + t) * 1024 + 512 + h * 128 + ch);
            *(u32x4*)(vb + t * 128 + ch) = *(const u32x4*)(Z + (size_t)(r0 + t) * NABP + C_V + h * 128 + ch); }
        for (int i = tid; i < 4096; i += NTHR) ((f32x4*)Cl)[i] = ((const f32x4*)(CST + (size_t)u * 16384))[i];
        if (tid < 128) nvec[tid] = NST[u * 128 + tid];
        __syncthreads();
        {
            const int t = tid >> 3, s0 = (tid & 7) * 8; float dot[8]; float qnp = 0.f;
#pragma unroll
            for (int i = 0; i < 8; ++i) dot[i] = 0.f;
            for (int d8 = 0; d8 < 16; ++d8) { float q8[8]; unpack8(*(const u32x4*)(qb + t * 128 + d8 * 8), q8);
                if ((d8 >> 1) == (tid & 7)) {
#pragma unroll
                    for (int e = 0; e < 8; ++e) qnp += q8[e] * nvec[d8 * 8 + e]; }
#pragma unroll
                for (int i = 0; i < 8; ++i) { float k8[8]; unpack8(*(const u32x4*)(kb + (s0 + i) * 128 + d8 * 8), k8);
#pragma unroll
                    for (int e = 0; e < 8; ++e) dot[i] += q8[e] * k8[e]; } }
            qnp += __shfl_xor(qnp, 1); qnp += __shfl_xor(qnp, 2); qnp += __shfl_xor(qnp, 4);
            if ((tid & 7) == 0) qn[t] = qnp;
            const float bm = btv[t] - mtv[t];
#pragma unroll
            for (int i = 0; i < 8; ++i) { const int s = s0 + i; S[t * 64 + s] = s <= t ? dot[i] * __expf(bm + libv[s]) : 0.f; }
        }
        __syncthreads();
        {
            const int t = tid >> 3, e0 = (tid & 7) * 16; float acc[16], aci[16]; float rs = 0.f;
#pragma unroll
            for (int e = 0; e < 16; ++e) { acc[e] = 0.f; aci[e] = 0.f; }
            for (int s = 0; s <= t; ++s) { const float a = S[t * 64 + s]; rs += a; float v0[8], v1[8]; unpack8(*(const u32x4*)(vb + s * 128 + e0), v0); unpack8(*(const u32x4*)(vb + s * 128 + e0 + 8), v1);
#pragma unroll
                for (int e = 0; e < 8; ++e) { acc[e] += a * v0[e]; acc[8 + e] += a * v1[e]; } }
#pragma unroll 2
            for (int d = 0; d < 128; ++d) { const float a = bf2f(qb[t * 128 + d]); const f32x4* cp = (const f32x4*)(Cl + d * 128 + e0);
#pragma unroll
                for (int q = 0; q < 4; ++q) { const f32x4 cv = cp[q]; aci[4 * q] += a * cv[0]; aci[4 * q + 1] += a * cv[1]; aci[4 * q + 2] += a * cv[2]; aci[4 * q + 3] += a * cv[3]; } }
            const float wi = wiv[t], den = wi * qn[t] + rs, dn = 1.f / fmaxf(fabsf(den), __expf(-mtv[t]));
            float ss = 0.f;
#pragma unroll
            for (int e = 0; e < 16; ++e) { acc[e] = (wi * aci[e] + acc[e]) * dn; ss += acc[e] * acc[e]; }
            ss += __shfl_xor(ss, 1); ss += __shfl_xor(ss, 2); ss += __shfl_xor(ss, 4);
            const float rstd = rsqrtf(ss * (1.f / 128.f) + EPSN);
            const bf16* op = Z + (size_t)(r0 + t) * NABP + C_O + h * 128 + e0; const float* og = P.ml_out_g + j * 512 + h * 128 + e0;
            float o0[8], o1[8]; unpack8(*(const u32x4*)op, o0); unpack8(*(const u32x4*)(op + 8), o1);
            u32x4 w0, w1;
            float r[16];
#pragma unroll
            for (int e = 0; e < 8; ++e) { r[e] = acc[e] * rstd * og[e] * sigmoidf_(o0[e]); r[8 + e] = acc[8 + e] * rstd * og[8 + e] * sigmoidf_(o1[e]); }
            w0.x = pk2(r[0], r[1]); w0.y = pk2(r[2], r[3]); w0.z = pk2(r[4], r[5]); w0.w = pk2(r[6], r[7]); w1.x = pk2(r[8], r[9]); w1.y = pk2(r[10], r[11]); w1.z = pk2(r[12], r[13]); w1.w = pk2(r[14], r[15]);
            bf16* mp = MIX + (size_t)(r0 + t) * 1024 + h * 128 + e0; *(u32x4*)mp = w0; *(u32x4*)(mp + 8) = w1;
        }
    }
    __syncthreads();
}

__device__ __forceinline__ void job_mlstm_sample(const Params& P, const Ctx& C0, int j) { unsigned char* const wsb = launder(P.ws); const Ctx C = relaunder(C0);
    const bf16* Z = (const bf16*)(wsb + WS_Z); const float* GT = (const float*)(wsb + WS_GATE); bf16* MIX = (bf16*)(wsb + WS_MIX);
    float* qf = (float*)C.lds; float* kf = qf + 512; float* vf = kf + 512; float* hb = vf + 512; float* S = hb + 512; float* sc = S + 16;
    const int tid = C.tid;
    for (int u = C.bid; u < 128; u += C.G) {
        const int sb = u >> 2, h = u & 3, r0 = MP + sb * 4;
        const float* C0 = P.st_C + ((size_t)(j * 32 + sb) * 4 + h) * 16384; const float* n0 = P.st_n + ((size_t)(j * 32 + sb) * 4 + h) * 128;
        __syncthreads();
        if (tid == 0) {
            const float m0 = P.st_m[(j * 32 + sb) * 4 + h]; float bt[4], li[4], pm = -INFINITY, b = 0.f;
#pragma unroll
            for (int t = 0; t < 4; ++t) { li[t] = GT[(size_t)(r0 + t) * 8 + h]; b += logsigmoidf_(GT[(size_t)(r0 + t) * 8 + 4 + h] + P.ml_f_bias[j * 4 + h]); bt[t] = b;
                pm = fmaxf(pm, li[t] - b); const float mt = b + fmaxf(m0, pm); sc[t] = b; sc[4 + t] = mt; sc[8 + t] = __expf(m0 + b - mt); }
            float gm = -INFINITY;
#pragma unroll
            for (int t = 0; t < 4; ++t) gm = fmaxf(gm, bt[3] - bt[t] + li[t]);
            const float mn = fmaxf(m0 + bt[3], gm);
#pragma unroll
            for (int t = 0; t < 4; ++t) { sc[12 + t] = __expf(bt[3] - bt[t] + li[t] - mn); sc[24 + t] = li[t] - bt[t]; }
            sc[20] = __expf(m0 + bt[3] - mn); P.out[O_SM + (j * 32 + sb) * 4 + h] = mn;
        }
        {
            const int cc = tid & 255, col = cc < 128 ? h * 128 + cc : 512 + h * 128 + (cc - 128);
            const float* cw = P.ml_conv_w + (size_t)j * 4 * 1024 + col; const float w0 = cw[0], w1 = cw[1024], w2 = cw[2048], w3 = cw[3072], cb = P.ml_conv_b[j * 1024 + col];
            const float* cbuf = P.st_conv + (size_t)(j * 32 + sb) * 3 * 1024 + col;
            float xs[7];
#pragma unroll
            for (int i = 0; i < 3; ++i) xs[i] = cbuf[i * 1024];
#pragma unroll
            for (int i = 0; i < 4; ++i) xs[3 + i] = bf2f(Z[(size_t)(r0 + i) * NABP + col]);
#pragma unroll
            for (int q = 0; q < 2; ++q) { const int t = (tid >> 8) * 2 + q;
                float y = cb;
                if (t == 0) y += w0 * xs[0] + w1 * xs[1] + w2 * xs[2] + w3 * xs[3]; else if (t == 1) y += w0 * xs[1] + w1 * xs[2] + w2 * xs[3] + w3 * xs[4];
                else if (t == 2) y += w0 * xs[2] + w1 * xs[3] + w2 * xs[4] + w3 * xs[5]; else y += w0 * xs[3] + w1 * xs[4] + w2 * xs[5] + w3 * xs[6];
                float s = siluf_(y); if (cc >= 128) { s *= 0.08838834764831845f; kf[t * 128 + cc - 128] = s; } else qf[t * 128 + cc] = s; }
            { const int t = tid >> 7, e = tid & 127; vf[tid] = bf2f(Z[(size_t)(r0 + t) * NABP + C_V + h * 128 + e]); }
        }
        __syncthreads();
        if (tid < 16) { const int t = tid >> 2, s = tid & 3; float d = 0.f; for (int k = 0; k < 128; ++k) d += qf[t * 128 + k] * kf[s * 128 + k];
            S[tid] = s <= t ? d * __expf(sc[t] - sc[4 + t] + sc[24 + s]) : 0.f; }
        else if (tid >= 64 && tid < 68) { const int t = tid - 64; float d = 0.f; for (int k = 0; k < 128; ++k) d += qf[t * 128 + k] * n0[k]; sc[16 + t] = d; }
        __syncthreads();
        { const int t = tid >> 7, e = tid & 127; float ai = 0.f;
            for (int d = 0; d < 128; ++d) ai += qf[t * 128 + d] * C0[d * 128 + e];
            float a = 0.f, rs = 0.f;
#pragma unroll
            for (int s = 0; s < 4; ++s) { a += S[t * 4 + s] * vf[s * 128 + e]; rs += S[t * 4 + s]; }
            const float wi = sc[8 + t], den = wi * sc[16 + t] + rs;
            hb[tid] = (wi * ai + a) / fmaxf(fabsf(den), __expf(-sc[4 + t])); }
        __syncthreads();
        { const int t = tid >> 7, e = tid & 127; float ss = 0.f; for (int k = 0; k < 128; ++k) ss += hb[t * 128 + k] * hb[t * 128 + k];
            const float rstd = rsqrtf(ss * (1.f / 128.f) + EPSN), o = bf2f(Z[(size_t)(r0 + t) * NABP + C_O + h * 128 + e]);
            MIX[(size_t)(r0 + t) * 1024 + h * 128 + e] = (bf16)f2bf(hb[tid] * rstd * P.ml_out_g[j * 512 + h * 128 + e] * sigmoidf_(o)); }
        { const float decay = sc[20]; float* Co = P.out + O_SC + ((size_t)(j * 32 + sb) * 4 + h) * 16384;
            for (int i = 0; i < 32; ++i) { const int idx = i * 512 + tid, d = idx >> 7, e = idx & 127; float a = decay * C0[idx];
#pragma unroll
                for (int s = 0; s < 4; ++s) a += sc[12 + s] * kf[s * 128 + d] * vf[s * 128 + e];
                Co[idx] = a; }
            if (tid < 128) { float a = decay * n0[tid];
#pragma unroll
                for (int s = 0; s < 4; ++s) a += sc[12 + s] * kf[s * 128 + tid];
                P.out[O_SN + ((size_t)(j * 32 + sb) * 4 + h) * 128 + tid] = a; } }
    }
    __syncthreads();
}

struct KeyRef { const void* k; const void* v; bool valid; };
template <bool F32>
__device__ __forceinline__ void load8f(const void* p, int off, float (&o)[8]) {
    if (F32) { const f32x4 a = *(const f32x4*)((const float*)p + off), b = *(const f32x4*)((const float*)p + off + 4); o[0] = a[0]; o[1] = a[1]; o[2] = a[2]; o[3] = a[3]; o[4] = b[0]; o[5] = b[1]; o[6] = b[2]; o[7] = b[3]; }
    else unpack8(*(const u32x4*)((const bf16*)p + off), o);
}
template <bool F32, class KF>
__device__ __forceinline__ void attn_branch(const KF& kf, int nk, const f32x4* qs, f32x4* sc, int lane, float (&o)[4], float (&inv)[4]) {
    float mx[4] = {-INFINITY, -INFINITY, -INFINITY, -INFINITY};
    for (int c0 = 0; c0 < nk; c0 += 64) {
        const int idx = c0 + lane; KeyRef kr; kr.valid = false; kr.k = nullptr; kr.v = nullptr;
        if (idx < nk) kr = kf(idx);
        float s[4] = {-INFINITY, -INFINITY, -INFINITY, -INFINITY};
        if (kr.valid) { s[0] = s[1] = s[2] = s[3] = 0.f;
#pragma unroll 2
            for (int d8 = 0; d8 < 8; ++d8) { float kk[8]; load8f<F32>(kr.k, d8 * 8, kk);
#pragma unroll
                for (int i = 0; i < 8; ++i) { const f32x4 q4 = qs[d8 * 8 + i]; s[0] += kk[i] * q4[0]; s[1] += kk[i] * q4[1]; s[2] += kk[i] * q4[2]; s[3] += kk[i] * q4[3]; } } }
        sc[idx] = (f32x4){s[0], s[1], s[2], s[3]};
#pragma unroll
        for (int r = 0; r < 4; ++r) mx[r] = fmaxf(mx[r], s[r]);
    }
    float sum[4] = {0.f, 0.f, 0.f, 0.f};
#pragma unroll
    for (int r = 0; r < 4; ++r) { mx[r] = wave_max(mx[r]); if (mx[r] == -INFINITY) mx[r] = 0.f; }
    for (int c0 = 0; c0 < nk; c0 += 64) { const int idx = c0 + lane; f32x4 s = sc[idx];
#pragma unroll
        for (int r = 0; r < 4; ++r) { s[r] = __expf(s[r] - mx[r]); sum[r] += s[r]; }
        sc[idx] = s; }
#pragma unroll
    for (int r = 0; r < 4; ++r) { sum[r] = wave_sum(sum[r]); inv[r] = sum[r] > 0.f ? 1.f / sum[r] : 1.f; o[r] = 0.f; }
    asm volatile("s_waitcnt lgkmcnt(0)" ::: "memory");
#pragma unroll 4
    for (int jj = 0; jj < nk; ++jj) {
        const KeyRef kr = kf(jj);
        if (!kr.valid) continue;
        const f32x4 p = sc[jj];
        const float vv = F32 ? ((const float*)kr.v)[lane] : bf2f(((const bf16*)kr.v)[lane]);
        o[0] += p[0] * vv; o[1] += p[1] * vv; o[2] += p[2] * vv; o[3] += p[3] * vv;
    }
#pragma unroll
    for (int r = 0; r < 4; ++r) o[r] *= inv[r];
}

__device__ __forceinline__ int nsa_select(const f32x4* sc, const float (&inv)[4], int ncv, int cur, int* sel, int lane) {
    float c[2];
#pragma unroll
    for (int q = 0; q < 2; ++q) { const int jb = lane + 64 * q; float a = 0.f;
        for (int n = 4 * jb - 1; n <= 4 * jb + 3; ++n) if (n >= 0 && n < ncv) { const f32x4 p = sc[n]; a += p[0] * inv[0] + p[1] * inv[1] + p[2] * inv[2] + p[3] * inv[3]; }
        c[q] = (jb >= 1 && jb <= cur - 2) ? a : -1.f; }
    int cnt = 0;
    if (lane == 0) { sel[cnt] = 0; } cnt++;
    if (cur >= 1) { if (lane == 0) sel[cnt] = cur; cnt++; }
    if (cur >= 2) { if (lane == 0) sel[cnt] = cur - 1; cnt++; }
    const int nfree = 16 - cnt;
    for (int it = 0; it < nfree; ++it) {
        float bv = c[0]; int bi = lane; if (c[1] > bv) { bv = c[1]; bi = lane + 64; }
#pragma unroll
        for (int o = 1; o < 64; o <<= 1) { const float ov = __shfl_xor(bv, o); const int oi = __shfl_xor(bi, o); if (ov > bv || (ov == bv && oi < bi)) { bv = ov; bi = oi; } }
        if (bv < 0.f) break;
        if (lane == 0) sel[cnt] = bi;
        cnt++;
        if (bi == lane) c[0] = -2.f; if (bi == lane + 64) c[1] = -2.f;
    }
    asm volatile("s_waitcnt lgkmcnt(0)" ::: "memory");
    return cnt;
}

template <bool DEC>
__device__ __forceinline__ void job_nsa_naive(const Params& P, const Ctx& C0, int j) { unsigned char* const wsb = launder(P.ws); const Ctx C = relaunder(C0);
    const bf16* Z = (const bf16*)(wsb + WS_Z); bf16* MIX = (bf16*)(wsb + WS_MIX);
    const float* KC = DEC ? (const float*)(wsb + WS_KCS) + (size_t)j * 2 * 32 * 512 * 128 : (const float*)(wsb + WS_KC);
    const int NB = DEC ? 32 : 2;
    const float* VC = KC + (size_t)NB * 512 * 128;
    f32x4* qs = (f32x4*)(C.lds + C.wave * 17664); f32x4* sc = qs + 64; int* sel = (int*)(sc + 1024 + 8);
    const int lane = C.lane, gw = C.bid * NWAVES + C.wave, NGW = C.G * NWAVES;
    const int nunit = DEC ? 32 * 4 * 2 : MP * 2;
    for (int u = gw; u < nunit; u += NGW) {
        const int g = u & 1, bt_ = u >> 1, b = DEC ? (bt_ >> 2) : (bt_ >> 13), t = DEC ? (bt_ & 3) : (bt_ & 8191);
        const int row = DEC ? MP + bt_ : bt_, qpos = DEC ? SEQ + t : t;
        const bf16* zr = Z + (size_t)row * NABP;
        { f32x4 q4;
#pragma unroll
          for (int r = 0; r < 4; ++r) q4[r] = bf2f(zr[C_QN + (g * 4 + r) * 64 + lane]) * 0.125f;
          qs[lane] = q4; }
        asm volatile("s_waitcnt lgkmcnt(0)" ::: "memory");
        float gt[4][3];
#pragma unroll
        for (int r = 0; r < 4; ++r)
#pragma unroll
            for (int q = 0; q < 3; ++q) gt[r][q] = sigmoidf_(bf2f(zr[C_GN + (g * 4 + r) * 3 + q]));
        float oc[4], os[4], ow[4], inv[4];
        const int ncv = DEC ? 511 : (qpos >= 31 ? (((qpos - 31) >> 4) + 1 > 511 ? 511 : ((qpos - 31) >> 4) + 1) : 0);
        { auto kf = [&](int idx) -> KeyRef { KeyRef k; const size_t o = ((size_t)(b * 512 + idx) * 2 + g) * 64; k.k = KC + o; k.v = VC + o; k.valid = idx < ncv; return k; };
          attn_branch<true>(kf, ncv, qs, sc, lane, oc, inv); }
        const int cur = qpos >> 6;
        const int nsel = nsa_select(sc, inv, ncv, cur, sel, lane);
        { auto kf = [&](int idx) -> KeyRef { KeyRef k; const int blk = sel[idx >> 6], pos = blk * 64 + (idx & 63); k.valid = pos <= qpos;
              if (DEC) { const float* base;
                  if (pos < SEQ) { const int page = P.page_table[b * 64 + (pos >> 7)]; base = P.cache + ((((size_t)j * NPOOL + page) * 128 + (pos & 127)) * 4 + 2) * 128 + g * 64; }
                  else base = P.out + O_SKV + (((size_t)(j * 32 + b) * 4 + (pos - SEQ > 3 ? 3 : pos - SEQ)) * 4 + 2) * 128 + g * 64;
                  k.k = base; k.v = base + 128; }
              else { const bf16* base = Z + (size_t)(b * SEQ + pos) * NABP + C_KV + 256 + g * 64; k.k = base; k.v = base + 128; }
              return k; };
          attn_branch<DEC>(kf, nsel * 64, qs, sc, lane, os, inv); }
        { auto kf = [&](int idx) -> KeyRef { KeyRef k;
              if (DEC) { k.valid = idx >= t && idx <= 512 + t;
                  const float* base = idx < 4 ? P.st_win + (((size_t)(j * 32 + b) * 512 + idx) * 2) * 128 + g * 64 : P.out + O_SWIN + (((size_t)(j * 32 + b) * 512 + (idx - 4)) * 2) * 128 + g * 64;
                  k.k = base; k.v = base + 128; }
              else { const int pos = qpos - 512 + idx; k.valid = pos >= 0; const bf16* base = Z + (size_t)(b * SEQ + (pos < 0 ? 0 : pos)) * NABP + C_WIN + g * 64; k.k = base; k.v = base + 128; }
              return k; };
          attn_branch<DEC>(kf, DEC ? 516 : 513, qs, sc, lane, ow, inv); }
#pragma unroll
        for (int r = 0; r < 4; ++r) MIX[(size_t)row * 1024 + 512 + (g * 4 + r) * 64 + lane] = (bf16)f2bf(gt[r][0] * oc[r] + gt[r][1] * os[r] + gt[r][2] * ow[r]);
    }
}

__device__ __forceinline__ void job_gate_prompt(const Params& P, const Ctx& C0, int jc) { unsigned char* const wsb = launder(P.ws); const Ctx C = relaunder(C0);
    const bf16* Z2 = (const bf16*)(wsb + WS_Z); bf16* MIX = (bf16*)(wsb + WS_MIX);
    bf16* vh = (bf16*)C.lds;
    float* wsl = (float*)(C.lds + 65536);
    float* rstd = (float*)(C.lds + 131072);
    const int tid = C.tid;
    for (int u = C.bid; u < 512; u += C.G) {
        const int ch = u >> 2, gq = u & 3, r0 = ch * 128;
        __syncthreads();
        for (int rr = C.wave; rr < 128; rr += NWAVES) { const bf16* vr = Z2 + (size_t)(r0 + rr) * 2048 + 1024; float a[8], b[8]; unpack8(*(const u32x4*)(vr + C.lane * 16), a); unpack8(*(const u32x4*)(vr + C.lane * 16 + 8), b);
            float s = 0.f;
#pragma unroll
            for (int e = 0; e < 8; ++e) s += a[e] * a[e] + b[e] * b[e];
            s = wave_sum(s); if (C.lane == 0) rstd[rr] = rsqrtf(s * (1.f / 1024.f) + EPSN); }
        for (int i = tid; i < 4096; i += NTHR) ((f32x4*)wsl)[i] = ((const f32x4*)(P.cl_ws + (size_t)(jc * 4 + gq) * 16384))[i];
        __syncthreads();
        for (int i = tid; i < 128 * 32; i += NTHR) { const int s = i >> 5, d0 = (i & 31) * 8; float a[8]; unpack8(*(const u32x4*)(Z2 + (size_t)(r0 + s) * 2048 + 1024 + gq * 256 + d0), a);
            const float rs = rstd[s]; const float* gv = P.cl_v_g + jc * 1024 + gq * 256 + d0; u32x4 w;
            w.x = pk2(a[0] * rs * gv[0], a[1] * rs * gv[1]); w.y = pk2(a[2] * rs * gv[2], a[3] * rs * gv[3]); w.z = pk2(a[4] * rs * gv[4], a[5] * rs * gv[5]); w.w = pk2(a[6] * rs * gv[6], a[7] * rs * gv[7]);
            *(u32x4*)(vh + s * 256 + d0) = w; }
        __syncthreads();
        const int t0 = (tid >> 5) * 8, d0 = (tid & 31) * 8;
        float acc[8][8];
#pragma unroll
        for (int a = 0; a < 8; ++a)
#pragma unroll
            for (int e = 0; e < 8; ++e) acc[a][e] = 0.f;
        for (int s = 0; s < t0 + 8; ++s) { float v8[8]; unpack8(*(const u32x4*)(vh + s * 256 + d0), v8);
#pragma unroll
            for (int a = 0; a < 8; ++a) { const float w = (s <= t0 + a) ? wsl[(t0 + a) * 128 + s] : 0.f;
#pragma unroll
                for (int e = 0; e < 8; ++e) acc[a][e] += w * v8[e]; } }
#pragma unroll
        for (int a = 0; a < 8; ++a) { const int t = t0 + a; const float bs = P.cl_bs[(jc * 4 + gq) * 128 + t]; float uu[8]; unpack8(*(const u32x4*)(Z2 + (size_t)(r0 + t) * 2048 + gq * 256 + d0), uu);
            u32x4 w; w.x = pk2(uu[0] * (acc[a][0] + bs), uu[1] * (acc[a][1] + bs)); w.y = pk2(uu[2] * (acc[a][2] + bs), uu[3] * (acc[a][3] + bs));
            w.z = pk2(uu[4] * (acc[a][4] + bs), uu[5] * (acc[a][5] + bs)); w.w = pk2(uu[6] * (acc[a][6] + bs), uu[7] * (acc[a][7] + bs));
            *(u32x4*)(MIX + (size_t)(r0 + t) * 1024 + gq * 256 + d0) = w; }
    }
    __syncthreads();
}
__device__ __forceinline__ void job_gate_sample(const Params& P, const Ctx& C0, int jc) { unsigned char* const wsb = launder(P.ws); const Ctx C = relaunder(C0);
    const bf16* Z2 = (const bf16*)(wsb + WS_Z); bf16* MIX = (bf16*)(wsb + WS_MIX);
    float* vh = (float*)C.lds; float* red = vh + 4096;
    const int tid = C.tid;
    for (int u = C.bid; u < 32; u += C.G) {
        const int r0 = MP + u * 4;
        __syncthreads();
        float v[8];
#pragma unroll
        for (int i = 0; i < 8; ++i) { const int idx = i * 512 + tid, t = idx >> 10, c = idx & 1023; v[i] = bf2f(Z2[(size_t)(r0 + t) * 2048 + 1024 + c]); }
#pragma unroll
        for (int t = 0; t < 4; ++t) { float s = v[2 * t] * v[2 * t] + v[2 * t + 1] * v[2 * t + 1]; s = wave_sum(s); if (C.lane == 0) red[t * 8 + C.wave] = s; }
        __syncthreads();
#pragma unroll
        for (int i = 0; i < 8; ++i) { const int idx = i * 512 + tid, t = idx >> 10, c = idx & 1023; float s = 0.f;
#pragma unroll
            for (int w = 0; w < 8; ++w) s += red[t * 8 + w];
            const float x = v[i] * rsqrtf(s * (1.f / 1024.f) + EPSN) * P.cl_v_g[jc * 1024 + c]; vh[idx] = x; P.out[O_SGV + ((size_t)(jc * 32 + u) * 4 + t) * 1024 + c] = x; }
        __syncthreads();
#pragma unroll
        for (int i = 0; i < 8; ++i) { const int idx = i * 512 + tid, t = idx >> 10, c = idx & 1023, gq = c >> 8; float s = P.cl_bs[(jc * 4 + gq) * 128 + t];
            for (int sp = 0; sp <= t; ++sp) s += P.cl_ws[(size_t)(jc * 4 + gq) * 16384 + t * 128 + sp] * vh[sp * 1024 + c];
            const float uu = bf2f(Z2[(size_t)(r0 + t) * 2048 + c]); MIX[(size_t)(r0 + t) * 1024 + c] = (bf16)f2bf(uu * s); }
    }
    __syncthreads();
}

#ifndef JOBMASK
#define JOBMASK 0xFFFFFFFFu
#endif
#define EN(n) ((JOBMASK >> (n)) & 1u)
__global__ void __launch_bounds__(NTHR, 2) trunk_fwd(Params P) {
    extern __shared__ __attribute__((aligned(16))) unsigned char lds[];
    Ctx C; C.lds = lds; C.tid = threadIdx.x; C.lane = C.tid & 63; C.wave = __builtin_amdgcn_readfirstlane(C.tid >> 6); C.bid = blockIdx.x; C.G = gridDim.x;
    volatile LAS unsigned* MISC = (volatile LAS unsigned*)((LAS unsigned char*)lds + MISC_OFF);
    if (C.tid < 64) MISC[C.tid] = 0u;
    __syncthreads();
    unsigned* ctl = (unsigned*)(P.ws + WS_CTL);
    const bool multi = (P.ph_hi - P.ph_lo) > 1;
    XcdBarrier bar; bar.bar = ctl + 4096; bar.x = 0; bar.st = nullptr;
    if (multi) bar = xcd_barrier_post(ctl + 4096, MISC + 8);
    const int lo = P.ph_lo, hi = P.ph_hi;
    int ph = 0;
#define IN() (lo <= ph && ph < hi)
#define SEAM() do { if (IN() && ph + 1 < hi) xcd_barrier(bar); ++ph; } while (0)
    LAS unsigned char* ldsl = (LAS unsigned char*)lds;

    if (IN()) { if(EN(0)) job_transposes(P, C); if(EN(1)) job_copy_x(P, C); if(EN(2)) job_adaln(P, C); }
    SEAM();
    if (IN()) { if(EN(3)) job_norm<false>(P, C, 0, 0); if(EN(4)) { job_compress1<true>(P, C, 0); job_compress1<true>(P, C, 1); } }
    SEAM();
    for (int l = 0; l < 4; ++l) {
        const int j = l >> 1;
        if ((l & 1) == 0) {
            if (IN()) { unsigned char* ws = launder(P.ws); pg8::Gemm g{(const bf16*)(ws + WS_H), (const bf16*)(ws + WS_WABIN) + (size_t)j * NABP * DM, MT, NABP, DM}; pg8::StaticOrder S; S.init(MT, NABP, C.G, C.bid);
                pg8::EpiAbIn E{(bf16*)(ws + WS_Z), P.ab_b_in + (size_t)j * NABV, (float*)(ws + WS_GATE), P.out, j};
                if(EN(16)) pg8::gemm_phase<pg8::EpiAbIn, pg8::StaticOrder, true, true>(ldsl, g, S, E); }
            SEAM();
            if (IN()) { if(EN(5)) job_mlstm_local(P, C, j); if(EN(4)) job_compress1<false>(P, C, j); if(EN(6)) job_mlstm_sample(P, C, j); if(EN(7)) job_compress2<true>(P, C, j); }
            SEAM();
            if (IN()) { if(EN(8)) job_mlstm_scan(P, C, j); if(EN(7)) job_compress2<false>(P, C, j); }
            SEAM();
            if (IN()) { if(EN(9)) job_mlstm_out(P, C, j); if(EN(10)) job_nsa_naive<false>(P, C, j); if(EN(11)) job_nsa_naive<true>(P, C, j); }
            SEAM();
        } else {
            if (IN()) { unsigned char* ws = launder(P.ws); pg8::Gemm g{(const bf16*)(ws + WS_H), (const bf16*)(ws + WS_WCLIN) + (size_t)j * 2048 * DM, MT, 2048, DM}; pg8::StaticOrder S; S.init(MT, 2048, C.G, C.bid);
                pg8::EpiAct<1> E{(bf16*)(ws + WS_Z), 2048, P.cl_b_in + (size_t)j * 2048};
                if(EN(17)) pg8::gemm_phase<pg8::EpiAct<1>, pg8::StaticOrder, true, true>(ldsl, g, S, E); }
            SEAM();
            if (IN()) { if(EN(12)) job_gate_prompt(P, C, j); if(EN(13)) job_gate_sample(P, C, j); }
            SEAM();
        }
        if (IN()) { unsigned char* ws = launder(P.ws); const bf16* Wt = (l & 1) ? (const bf16*)(ws + WS_WCLOUT) + (size_t)j * DM * DM : (const bf16*)(ws + WS_WABOUT) + (size_t)j * DM * DM;
            pg8::Gemm g{(const bf16*)(ws + WS_MIX), Wt, MT, DM, DM}; pg8::StaticOrder S; S.init(MT, DM, C.G, C.bid);
            pg8::EpiResid E{(float*)(ws + WS_X), (const float*)(ws + WS_MOD) + (size_t)l * 34 * 6144 + 2 * DM};
            if(EN(19)) pg8::gemm_phase<pg8::EpiResid, pg8::StaticOrder, true, true>(ldsl, g, S, E); }
        SEAM();
        if (IN()) { if(EN(3)) job_norm<false>(P, C, l, 1); }
        SEAM();
        if (IN()) { unsigned char* ws = launder(P.ws); pg8::Gemm g{(const bf16*)(ws + WS_H), (const bf16*)(ws + WS_WF1) + (size_t)l * FF * DM, MT, FF, DM}; pg8::StaticOrder S; S.init(MT, FF, C.G, C.bid);
            pg8::EpiAct<0> E{(bf16*)(ws + WS_ACT), FF, nullptr};
            if(EN(18)) pg8::gemm_phase<pg8::EpiAct<0>, pg8::StaticOrder, true, true>(ldsl, g, S, E); }
        SEAM();
        if (IN()) { unsigned char* ws = launder(P.ws); pg8::Gemm g{(const bf16*)(ws + WS_ACT), (const bf16*)(ws + WS_WF2) + (size_t)l * DM * FF, MT, DM, FF}; pg8::StaticOrder S; S.init(MT, DM, C.G, C.bid);
            pg8::EpiResid E{(float*)(ws + WS_X), (const float*)(ws + WS_MOD) + (size_t)l * 34 * 6144 + 5 * DM};
            if(EN(19)) pg8::gemm_phase<pg8::EpiResid, pg8::StaticOrder, true, true>(ldsl, g, S, E); }
        SEAM();
        if (IN()) { if(EN(3)) { if (l < 3) job_norm<false>(P, C, l + 1, 0); else job_norm<true>(P, C, 0, 0); } }
        SEAM();
    }
#undef IN
#undef SEAM
}
constexpr int N_PHASES = 2 + 2 * 9 + 2 * 7;

#ifndef MK_ONE_LAUNCH
#define MK_ONE_LAUNCH 0
#endif
extern "C" void kernel_launch(void* const* d_in, const int* in_sizes, int n_in, void* d_out, int out_size, void* d_ws, size_t ws_size, hipStream_t stream) {
    static int grid = 0;
    if (grid == 0) {
        if (n_in != 35 || out_size != (int)O_END || ws_size < WS_END) { fprintf(stderr, "kernel_launch: unexpected shapes (n_in %d out %d ws %zu)\n", n_in, out_size, ws_size); grid = -1; return; }
        int dev = 0, cus = 0, per_cu = 0;
        if (hipGetDevice(&dev) != hipSuccess || hipDeviceGetAttribute(&cus, hipDeviceAttributeMultiprocessorCount, dev) != hipSuccess) { grid = -1; return; }
        if (hipFuncSetAttribute((const void*)trunk_fwd, hipFuncAttributeMaxDynamicSharedMemorySize, LDS_BYTES) != hipSuccess) { fprintf(stderr, "kernel_launch: hipFuncSetAttribute failed\n"); grid = -1; return; }
        if (hipOccupancyMaxActiveBlocksPerMultiprocessor(&per_cu, (const void*)trunk_fwd, NTHR, LDS_BYTES) != hipSuccess || per_cu < 1) { fprintf(stderr, "kernel_launch: occupancy query says %d\n", per_cu); }
        (void)hipGetLastError();
        grid = cus;
    }
    if (grid < 0) return;
    (void)hipMemsetAsync((char*)d_ws + WS_CTL, 0, CTL_ZERO_BYTES, stream);
    Params p{};
    const float** fp = (const float**)&p.x_prompt;
    (void)fp;
    p.x_prompt = (const float*)d_in[0]; p.x_sample = (const float*)d_in[1]; p.c_prompt = (const float*)d_in[2]; p.c_sample = (const float*)d_in[3];
    p.st_conv = (const float*)d_in[4]; p.st_C = (const float*)d_in[5]; p.st_n = (const float*)d_in[6]; p.st_m = (const float*)d_in[7]; p.cache = (const float*)d_in[8]; p.st_win = (const float*)d_in[9];
    p.page_table = (const int*)d_in[10];
    p.ada_w = (const float*)d_in[11]; p.ada_b = (const float*)d_in[12]; p.norm_g = (const float*)d_in[13]; p.ab_w_in = (const float*)d_in[14]; p.ab_b_in = (const float*)d_in[15];
    p.ml_conv_w = (const float*)d_in[16]; p.ml_conv_b = (const float*)d_in[17]; p.ml_f_bias = (const float*)d_in[18]; p.ml_out_g = (const float*)d_in[19];
    p.phi_pe = (const float*)d_in[20]; p.phi_w1 = (const float*)d_in[21]; p.phi_b1 = (const float*)d_in[22]; p.phi_w2 = (const float*)d_in[23]; p.phi_b2 = (const float*)d_in[24];
    p.ab_w_out = (const float*)d_in[25]; p.cl_w_in = (const float*)d_in[26]; p.cl_b_in = (const float*)d_in[27]; p.cl_v_g = (const float*)d_in[28]; p.cl_ws = (const float*)d_in[29]; p.cl_bs = (const float*)d_in[30];
    p.cl_w_out = (const float*)d_in[31]; p.ffn_w1 = (const float*)d_in[32]; p.ffn_w2 = (const float*)d_in[33]; p.final_g = (const float*)d_in[34];
    p.out = (float*)d_out; p.ws = (unsigned char*)d_ws; p.pad = 0;
#if MK_ONE_LAUNCH
    p.ph_lo = 0; p.ph_hi = N_PHASES; p.li = 0;
    hipLaunchKernelGGL(trunk_fwd, dim3(grid), dim3(NTHR), LDS_BYTES, stream, p);
#else
    for (int k = 0; k < N_PHASES; ++k) { p.ph_lo = k; p.ph_hi = k + 1; p.li = k; hipLaunchKernelGGL(trunk_fwd, dim3(grid), dim3(NTHR), LDS_BYTES, stream, p); }
#endif
}
```

```cpp
#include <hip/hip_runtime.h>
#include <cstdio>
#include <cstdint>
namespace pg8 {
#define PG8_LAS __attribute__((address_space(3)))
typedef unsigned short bf16_t;
typedef short bf16x8 __attribute__((ext_vector_type(8)));
typedef float f32x4 __attribute__((ext_vector_type(4)));
typedef unsigned u32x4 __attribute__((ext_vector_type(4)));
constexpr int BM = 256, BK = 64, HALF = 128, HTB = HALF * BK * 2  , STAGE_BYTES = 8 * HTB, NXCD = 8, WGM = 8;

__host__ __device__ __forceinline__ int lds_byte(int r, int c) { const int st = (r >> 4) * 2 + (c >> 5), rr = r & 15, cc = c & 31, ob = rr * 64 + cc * 2; return st * 1024 + (ob ^ (((ob >> 9) & 1) << 5)); }
__host__ __device__ __forceinline__ void stage_rc(int b, int& R, int& C) { const int st = b / 1024, sb = b % 1024, swz = sb ^ (((sb >> 9) & 1) << 5); R = (st >> 1) * 16 + swz / 64; C = (st & 1) * 32 + (swz % 64) / 2; }
__host__ __device__ __forceinline__ int perm32(int rho) { const int n = rho >> 4, i = rho & 15; return 8 * (i >> 2) + 4 * n + (i & 3); }

struct Unit { int pm, pn; };
struct Gemm { const bf16_t* A; const bf16_t* Bt; int M, N, K; };

struct StaticOrder {
    int nM, nN, nwg, G, c;
    __host__ __device__ void init(int M, int N, int G_, int c_) { nM = M / BM; nN = N / BM; nwg = nM * nN; G = G_; c = c_; }
    __host__ __device__ bool next(int i, Unit& u) const {
        const long L = (long)i * G + c; if (L >= nwg) return false;
        int wgid = (int)L; { const int q = nwg / NXCD, r = nwg % NXCD, xcd = wgid % NXCD, off = wgid / NXCD; wgid = (xcd < r ? xcd * (q + 1) : r * (q + 1) + (xcd - r) * q) + off; }
        const int nig = WGM * nN, gid = wgid / nig, fm = gid * WGM, gsz = (nM - fm) < WGM ? (nM - fm) : WGM;
        u.pm = fm + ((wgid % nig) % gsz); u.pn = (wgid % nig) / gsz; return true;
    }
    __device__ __forceinline__ void a_ready(const Unit&) const {}
    __device__ __forceinline__ void done(const Unit&) const {}
};

__device__ __forceinline__ unsigned cvt_pk_bf16(float lo, float hi) { unsigned r; asm volatile("v_cvt_pk_bf16_f32 %0, %1, %2" : "=v"(r) : "v"(lo), "v"(hi)); return r; }
typedef float f32x2 __attribute__((ext_vector_type(2)));

template <class Epi, class Sched, bool ALIGN_EPI = false, bool SP2 = false>
__device__ __forceinline__ void gemm_phase(PG8_LAS unsigned char* lds, const Gemm g, const Sched& S, const Epi& E) {
    int tid_ = threadIdx.x; asm volatile("" : "+v"(tid_));
    const int tid = tid_, wid = __builtin_amdgcn_readfirstlane(tid >> 6), lane = tid & 63, wr = wid >> 2, wc = wid & 3, fr = lane & 15, fq = lane >> 4;
    const int K = g.K, nt = K / BK;
    unsigned voffA[2], voffB[2];
#pragma unroll
    for (int i = 0; i < 2; ++i) { int R, C; stage_rc(tid * 16 + i * 8192, R, C); const int Rb = Epi::PERM ? ((R & ~31) + perm32(R & 31)) : R;
        voffA[i] = (unsigned)(R * K + C) * 2u; voffB[i] = (unsigned)(Rb * K + C) * 2u; }
    const size_t kstep = (size_t)(BK * 2);
    const size_t hstep = (size_t)HALF * K * 2;
    const size_t tstep = 2 * hstep;
    const unsigned ldsw = (unsigned)wid * 1024u;
    const int aoff = lds_byte(wr * 64 + fr, fq * 8), boff = lds_byte(wc * 32 + fr, fq * 8);
#define PG8_SA(b, h) (((b) * 2 + (h)) * HTB)
#define PG8_SB(b, h) ((4 + (b) * 2 + (h)) * HTB)
#define PG8_STAGE(bufoff, gbase, voff) do { _Pragma("unroll") for (int _i = 0; _i < 2; ++_i) \
        __builtin_amdgcn_global_load_lds((const unsigned*)((const char*)(gbase) + (voff)[_i]), (PG8_LAS unsigned*)(lds + (bufoff) + ldsw + _i * 8192), 16, 0, 0); } while (0)
#define PG8_LDA(dst, b, h) do { _Pragma("unroll") for (int m = 0; m < 4; ++m) _Pragma("unroll") for (int k = 0; k < 2; ++k) dst[m][k] = *(const PG8_LAS bf16x8*)(lds + PG8_SA(b, h) + aoff + m * 2048 + k * 1024); } while (0)
#define PG8_LDB(dst, b, h) do { _Pragma("unroll") for (int n = 0; n < 2; ++n) _Pragma("unroll") for (int k = 0; k < 2; ++k) dst[n][k] = *(const PG8_LAS bf16x8*)(lds + PG8_SB(b, h) + boff + n * 2048 + k * 1024); } while (0)
#define PG8_MMA(ai, bj, At, Bt) do { __builtin_amdgcn_s_setprio(1); _Pragma("unroll") for (int m = 0; m < 4; ++m) _Pragma("unroll") for (int n = 0; n < 2; ++n) _Pragma("unroll") for (int k = 0; k < 2; ++k) \
        acc[ai][bj][m][n] = __builtin_amdgcn_mfma_f32_16x16x32_bf16(Bt[n][k], At[m][k], acc[ai][bj][m][n], 0, 0, 0); __builtin_amdgcn_s_setprio(0); } while (0)
#define PG8_WAIT_V(n) asm volatile("s_waitcnt vmcnt(" #n ")" ::: "memory")
#define PG8_WAIT_L(n) asm volatile("s_waitcnt lgkmcnt(" #n ")" ::: "memory")
#define PG8_BAR __builtin_amdgcn_s_barrier()
#define PG8_SCHED __builtin_amdgcn_sched_barrier(0)
    Unit cur, nxt; int ui = 0;
    if (!S.next(0, cur)) return;
    f32x4 acc[2][2][4][2];
#pragma unroll
    for (int a = 0; a < 2; ++a)
#pragma unroll
        for (int b = 0; b < 2; ++b)
#pragma unroll
            for (int m = 0; m < 4; ++m)
#pragma unroll
                for (int n = 0; n < 2; ++n) acc[a][b][m][n] = (f32x4){0.f, 0.f, 0.f, 0.f};
    bf16x8 At[4][2], B0[2][2], B1[2][2];
    const char* cA = (const char*)g.A + (size_t)cur.pm * tstep; const char* cB = (const char*)g.Bt + (size_t)cur.pn * tstep;
    S.a_ready(cur);
    if constexpr (SP2) {
        PG8_STAGE(PG8_SB(0, 0), cB, voffB); PG8_STAGE(PG8_SB(0, 1), cB + hstep, voffB); PG8_STAGE(PG8_SA(0, 0), cA, voffA); PG8_STAGE(PG8_SA(0, 1), cA + hstep, voffA);
        if (wr == 1) PG8_BAR;
        PG8_WAIT_V(2); PG8_BAR;
        PG8_STAGE(PG8_SB(1, 0), cB + kstep, voffB); PG8_STAGE(PG8_SA(1, 0), cA + kstep, voffA); PG8_STAGE(PG8_SB(1, 1), cB + hstep + kstep, voffB);
        PG8_WAIT_V(6); PG8_BAR;
    } else {
        PG8_STAGE(PG8_SB(0, 0), cB, voffB); PG8_STAGE(PG8_SA(0, 0), cA, voffA); PG8_STAGE(PG8_SB(0, 1), cB + hstep, voffB); PG8_STAGE(PG8_SA(0, 1), cA + hstep, voffA);
        if (wr == 1) PG8_BAR;
        PG8_WAIT_V(4); PG8_BAR;
        PG8_STAGE(PG8_SB(1, 0), cB + kstep, voffB); PG8_STAGE(PG8_SA(1, 0), cA + kstep, voffA); PG8_STAGE(PG8_SB(1, 1), cB + hstep + kstep, voffB);
        PG8_WAIT_V(6); PG8_BAR;
    }
    for (;;) {
        const bool has_next = S.next(ui + 1, nxt);
        const char* nA = has_next ? (const char*)g.A + (size_t)nxt.pm * tstep : cA; const char* nB = has_next ? (const char*)g.Bt + (size_t)nxt.pn * tstep : cB;
        for (int t = 0; t < nt; t += 2) {
            const bool last = (t == nt - 2);
            const char* a1 = cA + (size_t)(t + 1) * kstep;
            const char* a2 = last ? nA : cA + (size_t)(t + 2) * kstep; const char* b2 = last ? nB : cB + (size_t)(t + 2) * kstep;
            const char* a3 = a2 + kstep; const char* b3 = b2 + kstep;
            if (last && has_next) S.a_ready(nxt);
            if constexpr (SP2) {
            PG8_LDB(B0, 0, 0); PG8_LDB(B1, 0, 1); PG8_SCHED; PG8_LDA(At, 0, 0); PG8_STAGE(PG8_SA(1, 1), a1 + hstep, voffA);
            PG8_WAIT_V(8); PG8_WAIT_L(0); PG8_BAR; PG8_MMA(0, 0, At, B0); PG8_MMA(0, 1, At, B1); PG8_BAR; PG8_SCHED;
            PG8_LDA(At, 0, 1); PG8_STAGE(PG8_SB(0, 0), b2, voffB); PG8_STAGE(PG8_SB(0, 1), b2 + hstep, voffB); PG8_STAGE(PG8_SA(0, 0), a2, voffA);
            PG8_WAIT_V(8); PG8_WAIT_L(0); PG8_BAR; PG8_MMA(1, 0, At, B0); PG8_MMA(1, 1, At, B1); PG8_BAR; PG8_SCHED;
            PG8_LDB(B0, 1, 0); PG8_LDB(B1, 1, 1); PG8_SCHED; PG8_LDA(At, 1, 0); PG8_STAGE(PG8_SA(0, 1), a2 + hstep, voffA);
            PG8_WAIT_V(8); PG8_WAIT_L(0); PG8_BAR; PG8_MMA(0, 0, At, B0); PG8_MMA(0, 1, At, B1); PG8_BAR; PG8_SCHED;
            PG8_LDA(At, 1, 1); PG8_STAGE(PG8_SB(1, 0), b3, voffB); PG8_STAGE(PG8_SB(1, 1), b3 + hstep, voffB); PG8_STAGE(PG8_SA(1, 0), a3, voffA);
            PG8_WAIT_V(8); PG8_WAIT_L(0); PG8_BAR; PG8_MMA(1, 0, At, B0); PG8_MMA(1, 1, At, B1); PG8_BAR; PG8_SCHED;
            } else {
            PG8_LDB(B0, 0, 0); PG8_SCHED; PG8_LDA(At, 0, 0); PG8_STAGE(PG8_SA(1, 1), a1 + hstep, voffA);
            PG8_WAIT_L(8); PG8_BAR; PG8_WAIT_L(0); PG8_MMA(0, 0, At, B0); PG8_BAR; PG8_SCHED;
            PG8_LDB(B1, 0, 1); PG8_STAGE(PG8_SB(0, 0), b2, voffB);
            PG8_BAR; PG8_WAIT_L(0); PG8_MMA(0, 1, At, B1); PG8_BAR;
            PG8_LDA(At, 0, 1); PG8_STAGE(PG8_SA(0, 0), a2, voffA);
            PG8_BAR; PG8_WAIT_L(0); PG8_MMA(1, 0, At, B0); PG8_BAR; PG8_SCHED;
            PG8_STAGE(PG8_SB(0, 1), b2 + hstep, voffB);
            PG8_WAIT_V(6); PG8_BAR; PG8_MMA(1, 1, At, B1); PG8_BAR;
            PG8_LDB(B0, 1, 0); PG8_SCHED; PG8_LDA(At, 1, 0); PG8_STAGE(PG8_SA(0, 1), a2 + hstep, voffA);
            PG8_WAIT_L(8); PG8_BAR; PG8_WAIT_L(0); PG8_MMA(0, 0, At, B0); PG8_BAR; PG8_SCHED;
            PG8_LDB(B1, 1, 1); PG8_STAGE(PG8_SB(1, 0), b3, voffB);
            PG8_BAR; PG8_WAIT_L(0); PG8_MMA(0, 1, At, B1); PG8_BAR;
            PG8_LDA(At, 1, 1); PG8_STAGE(PG8_SA(1, 0), a3, voffA);
            PG8_BAR; PG8_WAIT_L(0); PG8_MMA(1, 0, At, B0); PG8_BAR; PG8_SCHED;
            PG8_STAGE(PG8_SB(1, 1), b3 + hstep, voffB);
            PG8_WAIT_V(6); PG8_BAR; PG8_MMA(1, 1, At, B1); PG8_BAR;
            }
        }
        if constexpr (ALIGN_EPI) { if (wr == 0) PG8_BAR; }
        if constexpr (!Epi::AFTER_DRAIN) { E(acc, cur, wr, wc, fr, fq); S.done(cur); }
        if (!has_next) break;
#pragma unroll
        for (int a = 0; a < 2; ++a)
#pragma unroll
            for (int b = 0; b < 2; ++b)
#pragma unroll
                for (int m = 0; m < 4; ++m)
#pragma unroll
                    for (int n = 0; n < 2; ++n) acc[a][b][m][n] = (f32x4){0.f, 0.f, 0.f, 0.f};
        cur = nxt; cA = nA; cB = nB; ++ui;
        if constexpr (ALIGN_EPI) { if (wr == 1) PG8_BAR; }
    }
    PG8_WAIT_V(0);
    if constexpr (!ALIGN_EPI) { if (wr == 0) PG8_BAR; }
    PG8_BAR;
    if constexpr (Epi::AFTER_DRAIN) { E.fused(acc, cur, wr, wc, fr, fq, lds, wid, lane); S.done(cur); }
#undef PG8_SA
#undef PG8_SB
#undef PG8_STAGE
#undef PG8_LDA
#undef PG8_LDB
#undef PG8_MMA
#undef PG8_WAIT_V
#undef PG8_WAIT_L
#undef PG8_BAR
#undef PG8_SCHED
}
}

#define GAS __attribute__((address_space(1)))
#define LAS __attribute__((address_space(3)))
typedef unsigned short bf16;
typedef float f32x4 __attribute__((ext_vector_type(4)));
typedef short bf16x8 __attribute__((ext_vector_type(8)));
typedef unsigned u32x4 __attribute__((ext_vector_type(4)));
typedef unsigned u32x2 __attribute__((ext_vector_type(2)));

constexpr int DM = 1024, SEQ = 8192, MP = 16384, MS = 128, MV = MP + MS, MT = 16640;
constexpr int NABP = 3584, NABV = 3360, FF = 4096;
constexpr int C_V = 1024, C_O = 1536, C_I = 2048, C_QN = 2056, C_KV = 2568, C_WIN = 3080, C_GN = 3336;
constexpr int NPOOL = 2560;
constexpr float EPSN = 1e-6f;

constexpr size_t O_YP = 0, O_YS = O_YP + 16777216, O_PCONV = O_YS + 131072, O_PC = O_PCONV + 12288, O_PN = O_PC + 262144, O_PM = O_PN + 2048,
                 O_PKV = O_PM + 16, O_PWIN = O_PKV + 16777216, O_SCONV = O_PWIN + 524288, O_SC = O_SCONV + 196608, O_SN = O_SC + 4194304,
                 O_SM = O_SN + 32768, O_SKV = O_SM + 256, O_SWIN = O_SKV + 131072, O_SGV = O_SWIN + 8388608, O_END = O_SGV + 262144;

constexpr size_t MiB = 1u << 20;
constexpr size_t WS_CTL = 0, CTL_ZERO_BYTES = 1 * MiB;
constexpr size_t WS_MOD = 1 * MiB;
constexpr size_t WS_PEC = 6 * MiB;
constexpr size_t WS_WABIN = 8 * MiB;
constexpr size_t WS_WABOUT = 24 * MiB;
constexpr size_t WS_WCLIN = 28 * MiB;
constexpr size_t WS_WCLOUT = 36 * MiB;
constexpr size_t WS_WF1 = 40 * MiB;
constexpr size_t WS_WF2 = 72 * MiB;
constexpr size_t WS_WPHI = 104 * MiB;
constexpr size_t WS_X = 112 * MiB;
constexpr size_t WS_H = 180 * MiB;
constexpr size_t WS_Z = 216 * MiB;
constexpr size_t WS_MIX = 332 * MiB;
constexpr size_t WS_ACT = 368 * MiB;
constexpr size_t WS_GATE = 500 * MiB;
constexpr size_t WS_QK = 504 * MiB;
constexpr size_t WS_G = 540 * MiB;
constexpr size_t WS_CST = 608 * MiB;
constexpr size_t WS_NU = 672 * MiB;
constexpr size_t WS_NST = 673 * MiB;
constexpr size_t WS_CHK = 674 * MiB;
constexpr size_t WS_MST = 675 * MiB;
constexpr size_t WS_KC = 676 * MiB;
constexpr size_t WS_KCS = 680 * MiB;
constexpr size_t WS_A01P = 716 * MiB;
constexpr size_t WS_A01S = 720 * MiB;
constexpr size_t WS_END = 800 * MiB;

constexpr int LDS_BYTES = 163840 - 2048;
constexpr int MISC_OFF = LDS_BYTES - 256;
constexpr int NWAVES = 8, NTHR = 512;

template <class T> __device__ __forceinline__ T* launder(T* p) { asm volatile("" : "+s"(p)); return p; }
__device__ __forceinline__ float bf2f(unsigned h) { return __uint_as_float(h << 16); }
__device__ __forceinline__ unsigned f2bf(float f) { unsigned u = __float_as_uint(f); return (u + 0x7fffu + ((u >> 16) & 1u)) >> 16; }
__device__ __forceinline__ unsigned pk2(float lo, float hi) { return f2bf(lo) | (f2bf(hi) << 16); }
__device__ __forceinline__ float wave_sum(float v) {
#pragma unroll
    for (int o = 1; o < 64; o <<= 1) v += __shfl_xor(v, o);
    return v;
}
__device__ __forceinline__ float wave_max(float v) {
#pragma unroll
    for (int o = 1; o < 64; o <<= 1) v = fmaxf(v, __shfl_xor(v, o));
    return v;
}
__device__ __forceinline__ float sigmoidf_(float x) { return 1.f / (1.f + __expf(-x)); }
__device__ __forceinline__ float siluf_(float x) { return x / (1.f + __expf(-x)); }
__device__ __forceinline__ float logsigmoidf_(float x) { return fminf(x, 0.f) - log1pf(__expf(-fabsf(x))); }
__device__ __forceinline__ float gelu_tanh(float x) { const float u = 1.5957691216f * (x + 0.044715f * x * x * x); return x / (1.f + __expf(-u)); }
__device__ __forceinline__ int mbidx(int row) { return row < MP ? (row >> 13) : 2 + (((row - MP) >> 2) > 31 ? 31 : ((row - MP) >> 2)); }
__device__ __forceinline__ void unpack8(const u32x4 w, float (&o)[8]) {
    o[0] = bf2f(w.x & 0xffffu); o[1] = bf2f(w.x >> 16); o[2] = bf2f(w.y & 0xffffu); o[3] = bf2f(w.y >> 16);
    o[4] = bf2f(w.z & 0xffffu); o[5] = bf2f(w.z >> 16); o[6] = bf2f(w.w & 0xffffu); o[7] = bf2f(w.w >> 16);
}

#define XB_TMO      128
#define XB_XCNT(j)  (256  + 64 * (j))
#define XB_XSUB(j)  (1280 + 64 * (j))
#define XB_XGEN(j)  (2304 + 64 * (j))
#define XB_TOP      3328
#define XB_TOPGEN   3392
#define XCD_BAR_WORDS 3456
#define XB_SPIN_CAP (1u << 18)
__device__ __forceinline__ unsigned xb_ld(unsigned* p)              { return __hip_atomic_load(p, __ATOMIC_RELAXED, __HIP_MEMORY_SCOPE_AGENT); }
__device__ __forceinline__ unsigned xb_add(unsigned* p, unsigned v) { return __hip_atomic_fetch_add(p, v, __ATOMIC_RELAXED, __HIP_MEMORY_SCOPE_AGENT); }
__device__ __forceinline__ unsigned xb_xcc_id() { return (unsigned)__builtin_amdgcn_s_getreg((3 << 11) | 20) & 0xFu; }
#define XB_SPIN(cond, bar) do { unsigned _sp = 0; while (cond) { __builtin_amdgcn_s_sleep(1); \
    if ((++_sp & 255u) == 0u) { if (xb_ld(&(bar)[XB_TMO])) break; if (_sp > XB_SPIN_CAP) { atomicAdd(&(bar)[XB_TMO], 1u); break; } } } } while (0)
struct XcdBarrier { unsigned* bar; unsigned x; volatile LAS unsigned* st; };
__device__ __forceinline__ XcdBarrier xcd_barrier_post(unsigned* bar, volatile LAS unsigned* st) {
    XcdBarrier b; b.bar = bar; b.x = xb_xcc_id(); b.st = st;
    if (threadIdx.x == 0) (void)xb_add(&bar[XB_XCNT(b.x)], 1u);
    return b;
}
__device__ __forceinline__ void xcd_barrier_complete(unsigned* bar, unsigned x, unsigned& nloc, unsigned& nx) {
    const unsigned G = gridDim.x * gridDim.y * gridDim.z;
    unsigned sum, cnt, mine, sp = 0u;
    for (;;) {
        sum = 0u; cnt = 0u; mine = 0u;
#pragma unroll
        for (unsigned j = 0; j < 16; ++j) { const unsigned c = xb_ld(&bar[XB_XCNT(j)]); sum += c; cnt += (c > 0u) ? 1u : 0u; mine = (j == x) ? c : mine; }
        if (sum == G) break;
        __builtin_amdgcn_s_sleep(1);
        if ((++sp & 255u) == 0u) { if (xb_ld(&bar[XB_TMO])) break; if (sp > XB_SPIN_CAP) { atomicAdd(&bar[XB_TMO], 1u); break; } }
    }
    nloc = mine > 0u ? mine : 1u; nx = cnt > 0u ? cnt : 1u;
}
__device__ __forceinline__ void xcd_barrier(const XcdBarrier& b) {
    asm volatile("s_waitcnt vmcnt(0)" ::: "memory");
    __syncthreads();
    if (threadIdx.x == 0) {
        unsigned* bar = b.bar;
        __builtin_amdgcn_s_waitcnt(0);
        unsigned nloc = b.st[0], nx = b.st[1];
        if (nloc == 0u) { xcd_barrier_complete(bar, b.x, nloc, nx); b.st[0] = nloc; b.st[1] = nx; }
        const unsigned old = xb_add(&bar[XB_XSUB(b.x)], 1u);
        const unsigned gen = old / nloc;
        if (old + 1u == (gen + 1u) * nloc) {
            __builtin_amdgcn_fence(__ATOMIC_RELEASE, "agent");
            asm volatile("s_waitcnt vmcnt(0)" ::: "memory");
            const unsigned og = xb_add(&bar[XB_TOP], 1u);
            const unsigned tg = og / nx;
            if (og + 1u == (tg + 1u) * nx) xb_add(&bar[XB_TOPGEN], 1u);
            else XB_SPIN(xb_ld(&bar[XB_TOPGEN]) == tg, bar);
            __builtin_amdgcn_fence(__ATOMIC_ACQUIRE, "agent");
            xb_add(&bar[XB_XGEN(b.x)], 1u);
            asm volatile("s_waitcnt vmcnt(0)" ::: "memory");
        } else {
            XB_SPIN(xb_ld(&bar[XB_XGEN(b.x)]) == gen, bar);
            __builtin_amdgcn_fence(__ATOMIC_ACQUIRE, "agent");
            asm volatile("s_waitcnt vmcnt(0)" ::: "memory");
        }
    }
    __syncthreads();
}

struct Params {
    const float *x_prompt, *x_sample, *c_prompt, *c_sample, *st_conv, *st_C, *st_n, *st_m, *cache, *st_win;
    const int* page_table;
    const float *ada_w, *ada_b, *norm_g, *ab_w_in, *ab_b_in, *ml_conv_w, *ml_conv_b, *ml_f_bias, *ml_out_g, *phi_pe, *phi_w1, *phi_b1, *phi_w2, *phi_b2,
                *ab_w_out, *cl_w_in, *cl_b_in, *cl_v_g, *cl_ws, *cl_bs, *cl_w_out, *ffn_w1, *ffn_w2, *final_g;
    float* out; unsigned char* ws;
    int ph_lo, ph_hi, li, pad;
};

namespace pg8 {
__device__ __forceinline__ u32x4 pack8(const f32x4 a, const f32x4 b) { u32x4 w; w.x = cvt_pk_bf16(a[0], a[1]); w.y = cvt_pk_bf16(a[2], a[3]); w.z = cvt_pk_bf16(b[0], b[1]); w.w = cvt_pk_bf16(b[2], b[3]); return w; }
struct EpiAbIn {
    static constexpr bool PERM = true, AFTER_DRAIN = false;
    bf16_t* Z; const float* bias; float* gate; float* out; int j;
    __device__ __forceinline__ void operator()(const f32x4 (&acc)[2][2][4][2], const Unit& u, int wr, int wc, int fr, int fq) const {
#pragma unroll
        for (int bj = 0; bj < 2; ++bj) {
            const int col = u.pn * BM + bj * HALF + wc * 32 + 8 * fq;
            if (col >= NABV) continue;
            const f32x4 b0 = *(const f32x4*)(bias + col), b1 = *(const f32x4*)(bias + col + 4);
#pragma unroll
            for (int ai = 0; ai < 2; ++ai)
#pragma unroll
                for (int m = 0; m < 4; ++m) {
                    const int row = u.pm * BM + ai * HALF + wr * 64 + m * 16 + fr;
                    if (row >= MV) continue;
                    const f32x4 v0 = acc[ai][bj][m][0] + b0, v1 = acc[ai][bj][m][1] + b1;
                    *(u32x4*)(Z + (size_t)row * NABP + col) = pack8(v0, v1);
                    float* dst = nullptr;
                    const bool isp = row < MP; const int b = isp ? (row >> 13) : ((row - MP) >> 2), t = isp ? (row & 8191) : ((row - MP) & 3);
                    if (col >= C_I && col < C_I + 8) dst = gate + (size_t)row * 8;
                    else if (col < 1024) { if (isp) { if (t >= SEQ - 3) dst = out + O_PCONV + ((size_t)(j * 2 + b) * 3 + (t - (SEQ - 3))) * 1024 + col; }
                                           else if (t >= 1) dst = out + O_SCONV + ((size_t)(j * 32 + b) * 3 + (t - 1)) * 1024 + col; }
                    else if (col >= C_KV && col < C_WIN) { dst = isp ? out + O_PKV + ((size_t)(j * 2 + b) * SEQ + t) * 512 + (col - C_KV) : out + O_SKV + ((size_t)(j * 32 + b) * 4 + t) * 512 + (col - C_KV); }
                    else if (col >= C_WIN && col < C_GN) { if (isp) { if (t >= SEQ - 512) dst = out + O_PWIN + ((size_t)(j * 2 + b) * 512 + (t - (SEQ - 512))) * 256 + (col - C_WIN); }
                                                           else dst = out + O_SWIN + ((size_t)(j * 32 + b) * 512 + 508 + t) * 256 + (col - C_WIN); }
                    if (dst) { *(f32x4*)dst = v0; *(f32x4*)(dst + 4) = v1; }
                }
        }
    }
};
struct EpiResid {
    static constexpr bool PERM = false, AFTER_DRAIN = false;
    float* X; const float* mod;
    __device__ __forceinline__ void operator()(const f32x4 (&acc)[2][2][4][2], const Unit& u, int wr, int wc, int fr, int fq) const {
#pragma unroll
        for (int ai = 0; ai < 2; ++ai)
#pragma unroll
            for (int m = 0; m < 4; ++m) {
                const int row = u.pm * BM + ai * HALF + wr * 64 + m * 16 + fr;
                if (row >= MV) continue;
                const float* g = mod + (size_t)mbidx(row) * 6144; float* xr = X + (size_t)row * DM;
#pragma unroll
                for (int bj = 0; bj < 2; ++bj)
#pragma unroll
                    for (int n = 0; n < 2; ++n) { const int col = u.pn * BM + bj * HALF + wc * 32 + 16 * n + 4 * fq;
                        const f32x4 gv = *(const f32x4*)(g + col); f32x4 xv = *(const f32x4*)(xr + col); xv = xv + gv * acc[ai][bj][m][n]; *(f32x4*)(xr + col) = xv; }
            }
    }
};
template <int ACT> struct EpiAct {
    static constexpr bool PERM = true, AFTER_DRAIN = false;
    bf16_t* O; int ldc; const float* bias;
    __device__ __forceinline__ void operator()(const f32x4 (&acc)[2][2][4][2], const Unit& u, int wr, int wc, int fr, int fq) const {
#pragma unroll
        for (int bj = 0; bj < 2; ++bj) {
            const int col = u.pn * BM + bj * HALF + wc * 32 + 8 * fq;
            f32x4 b0 = (f32x4){0.f, 0.f, 0.f, 0.f}, b1 = b0;
            if (ACT == 1) { b0 = *(const f32x4*)(bias + col); b1 = *(const f32x4*)(bias + col + 4); }
#pragma unroll
            for (int ai = 0; ai < 2; ++ai)
#pragma unroll
                for (int m = 0; m < 4; ++m) {
                    const int row = u.pm * BM + ai * HALF + wr * 64 + m * 16 + fr;
                    f32x4 v0 = acc[ai][bj][m][0] + b0, v1 = acc[ai][bj][m][1] + b1;
#pragma unroll
                    for (int e = 0; e < 4; ++e) {
                        if (ACT == 0) { const float a = fmaxf(v0[e], 0.f), c = fmaxf(v1[e], 0.f); v0[e] = a * a; v1[e] = c * c; }
                        else { v0[e] = gelu_tanh(v0[e]); v1[e] = gelu_tanh(v1[e]); }
                    }
                    *(u32x4*)(O + (size_t)row * ldc + col) = pack8(v0, v1);
                }
        }
    }
};
}

template <class LA, class LB, class EP>
__device__ __forceinline__ void tile_gemm_64x128(unsigned char* lds, int tid, int K, const LA& la, const LB& lb, const EP& epi) {
    const int lane = tid & 63, wid = tid >> 6, wm = wid >> 2, wn = wid & 3, fr = lane & 15, fq = lane >> 4;
    bf16* As = (bf16*)lds; bf16* Bs = (bf16*)(lds + 64 * 144);
    const int lr = tid >> 3, lk = (tid & 7) * 8;
    f32x4 acc[2][2];
#pragma unroll
    for (int a = 0; a < 2; ++a)
#pragma unroll
        for (int b = 0; b < 2; ++b) acc[a][b] = (f32x4){0.f, 0.f, 0.f, 0.f};
    bf16x8 ra = la(lr, lk), rb0 = lb(lr, lk), rb1 = lb(lr + 64, lk);
    for (int k0 = 0; k0 < K; k0 += 64) {
        __syncthreads();
        *(bf16x8*)(As + lr * 72 + lk) = ra; *(bf16x8*)(Bs + lr * 72 + lk) = rb0; *(bf16x8*)(Bs + (lr + 64) * 72 + lk) = rb1;
        __syncthreads();
        if (k0 + 64 < K) { ra = la(lr, k0 + 64 + lk); rb0 = lb(lr, k0 + 64 + lk); rb1 = lb(lr + 64, k0 + 64 + lk); }
#pragma unroll
        for (int ks = 0; ks < 2; ++ks) {
            bf16x8 af[2], bfv[2];
#pragma unroll
            for (int i = 0; i < 2; ++i) { af[i] = *(const bf16x8*)(As + (wm * 32 + i * 16 + fr) * 72 + ks * 32 + fq * 8); bfv[i] = *(const bf16x8*)(Bs + (wn * 32 + i * 16 + fr) * 72 + ks * 32 + fq * 8); }
#pragma unroll
            for (int mi = 0; mi < 2; ++mi)
#pragma unroll
                for (int ni = 0; ni < 2; ++ni) acc[mi][ni] = __builtin_amdgcn_mfma_f32_16x16x32_bf16(bfv[ni], af[mi], acc[mi][ni], 0, 0, 0);
        }
    }
#pragma unroll
    for (int mi = 0; mi < 2; ++mi)
#pragma unroll
        for (int ni = 0; ni < 2; ++ni) epi(wm * 32 + mi * 16 + fr, wn * 32 + ni * 16 + 4 * fq, acc[mi][ni]);
    __syncthreads();
}

struct Ctx { unsigned char* lds; int tid, lane, wave, bid, G; };
__device__ __forceinline__ Ctx relaunder(const Ctx& C0) {
    Ctx C = C0; asm volatile("" : "+v"(C.tid)); asm volatile("" : "+s"(C.lds)); asm volatile("" : "+s"(C.bid)); C.lane = C.tid & 63; C.wave = __builtin_amdgcn_readfirstlane(C.tid >> 6); return C; }

__device__ __forceinline__ void transpose_item(const float* W, int K, int N, bf16* WT, int item, float* scr, int lane) {
    const int nblk = N / 32, kb = item / nblk, nb = item % nblk, k0 = 64 * kb, n0 = 32 * nb;
#pragma unroll 8
    for (int i = 0; i < 32; ++i) { const int kk = 2 * i + (lane >> 5); scr[kk * 33 + (lane & 31)] = W[(size_t)(k0 + kk) * N + n0 + (lane & 31)]; }
    asm volatile("s_waitcnt lgkmcnt(0)" ::: "memory");
    const int c = lane & 7;
#pragma unroll
    for (int j = 0; j < 4; ++j) { const int n = (lane >> 3) + 8 * j; const float* s = scr + (8 * c) * 33 + n;
        u32x4 o; o.x = pk2(s[0 * 33], s[1 * 33]); o.y = pk2(s[2 * 33], s[3 * 33]); o.z = pk2(s[4 * 33], s[5 * 33]); o.w = pk2(s[6 * 33], s[7 * 33]);
        *(u32x4*)(WT + (size_t)(n0 + n) * K + k0 + 8 * c) = o; }
    asm volatile("s_waitcnt lgkmcnt(0)" ::: "memory");
}

__device__ __forceinline__ void job_transposes(const Params& P, const Ctx& C0) { unsigned char* const wsb = launder(P.ws); const Ctx C = relaunder(C0);
    float* scr = (float*)(C.lds + C.wave * 8448);
    const int gw = C.bid * NWAVES + C.wave, NGW = C.G * NWAVES;
    constexpr int I_ABIN = 16 * 105, I_SQ = 16 * 32, I_CLIN = 16 * 64, I_F1 = 16 * 128, I_F2 = 64 * 32, I_PHI = 16 * 2;
    constexpr int NIT = 2 * I_ABIN + 2 * I_SQ + 2 * I_CLIN + 2 * I_SQ + 4 * I_F1 + 4 * I_F2 + 8 * I_PHI;
    unsigned char* ws = wsb;
    for (int it = gw; it < NIT; it += NGW) {
        int r = it;
        if (r < 2 * I_ABIN) { const int j = r / I_ABIN; transpose_item(P.ab_w_in + (size_t)j * DM * NABV, DM, NABV, (bf16*)(ws + WS_WABIN) + (size_t)j * NABP * DM, r % I_ABIN, scr, C.lane); continue; } r -= 2 * I_ABIN;
        if (r < 2 * I_SQ) { const int j = r / I_SQ; transpose_item(P.ab_w_out + (size_t)j * DM * DM, DM, DM, (bf16*)(ws + WS_WABOUT) + (size_t)j * DM * DM, r % I_SQ, scr, C.lane); continue; } r -= 2 * I_SQ;
        if (r < 2 * I_CLIN) { const int j = r / I_CLIN; transpose_item(P.cl_w_in + (size_t)j * DM * 2048, DM, 2048, (bf16*)(ws + WS_WCLIN) + (size_t)j * 2048 * DM, r % I_CLIN, scr, C.lane); continue; } r -= 2 * I_CLIN;
        if (r < 2 * I_SQ) { const int j = r / I_SQ; transpose_item(P.cl_w_out + (size_t)j * DM * DM, DM, DM, (bf16*)(ws + WS_WCLOUT) + (size_t)j * DM * DM, r % I_SQ, scr, C.lane); continue; } r -= 2 * I_SQ;
        if (r < 4 * I_F1) { const int l = r / I_F1; transpose_item(P.ffn_w1 + (size_t)l * DM * FF, DM, FF, (bf16*)(ws + WS_WF1) + (size_t)l * FF * DM, r % I_F1, scr, C.lane); continue; } r -= 4 * I_F1;
        if (r < 4 * I_F2) { const int l = r / I_F2; transpose_item(P.ffn_w2 + (size_t)l * FF * DM, FF, DM, (bf16*)(ws + WS_WF2) + (size_t)l * DM * FF, r % I_F2, scr, C.lane); continue; } r -= 4 * I_F2;
        { const int q = r / I_PHI;
          transpose_item(P.phi_w1 + ((size_t)(q >> 1) * 2048 + (size_t)(q & 1) * 1024) * 64, 1024, 64, (bf16*)(ws + WS_WPHI) + ((size_t)(q >> 1) * 128 + (size_t)(q & 1) * 64) * 1024, r % I_PHI, scr, C.lane); }
    }
    const int gt = C.bid * NTHR + C.tid, NGT = C.G * NTHR;
    for (int i = gt; i < 2 * (NABP - NABV) * DM / 8; i += NGT) { const int j = i / ((NABP - NABV) * DM / 8), o = i % ((NABP - NABV) * DM / 8);
        *(u32x4*)((bf16*)(ws + WS_WABIN) + ((size_t)j * NABP + NABV) * DM + (size_t)o * 8) = (u32x4){0u, 0u, 0u, 0u}; }
}

__device__ __forceinline__ void job_copy_x(const Params& P, const Ctx& C0) { unsigned char* const wsb = launder(P.ws); const Ctx C = relaunder(C0);
    float* X = (float*)(wsb + WS_X);
    const int gw = C.bid * NWAVES + C.wave, NGW = C.G * NWAVES;
    for (int r = gw; r < MT; r += NGW) {
        f32x4* dst = (f32x4*)(X + (size_t)r * DM) + C.lane;
        if (r < MV) { const f32x4* src = (const f32x4*)(r < MP ? P.x_prompt + (size_t)r * DM : P.x_sample + (size_t)(r - MP) * DM) + C.lane;
#pragma unroll
            for (int i = 0; i < 4; ++i) dst[64 * i] = src[64 * i]; }
        else {
#pragma unroll
            for (int i = 0; i < 4; ++i) dst[64 * i] = (f32x4){0.f, 0.f, 0.f, 0.f}; }
    }
    const int gt = C.bid * NTHR + C.tid, NGT = C.G * NTHR;
    for (int i = gt; i < 64 * 508 * 64; i += NGT) { const int jb = i / (508 * 64), o = i % (508 * 64);
        ((f32x4*)(P.out + O_SWIN + (size_t)jb * 512 * 256))[o] = ((const f32x4*)(P.st_win + (size_t)jb * 512 * 256 + 4 * 256))[o]; }
    if (gw < 4) { const float* pe = P.phi_pe + (size_t)gw * 2048; const float* w1 = P.phi_w1 + (size_t)gw * 2048 * 64; float a = P.phi_b1[gw * 64 + C.lane];
        for (int kk = 0; kk < 2048; ++kk) a += pe[kk] * w1[(size_t)kk * 64 + C.lane];
        ((float*)(wsb + WS_PEC))[gw * 64 + C.lane] = a; }
}

__device__ __forceinline__ void job_adaln(const Params& P, const Ctx& C0) { unsigned char* const wsb = launder(P.ws); const Ctx C = relaunder(C0);
    float* SC = (float*)C.lds;
    __syncthreads();
    for (int i = C.tid; i < 34 * 1024; i += NTHR) { const int mb = i >> 10, k = i & 1023; const float c = mb < 2 ? P.c_prompt[mb * 1024 + k] : P.c_sample[(mb - 2) * 1024 + k]; SC[k * 36 + mb] = siluf_(c); }
    __syncthreads();
    float* MOD = (float*)(wsb + WS_MOD);
    const int gw = C.bid * NWAVES + C.wave, NGW = C.G * NWAVES, ks = C.lane >> 4, cl = C.lane & 15;
    for (int u = gw; u < 4 * 384; u += NGW) {
        const int l = u / 384, n = (u % 384) * 16 + cl;
        const float* w = P.ada_w + (size_t)l * DM * 6144 + n;
        float acc[34];
#pragma unroll
        for (int i = 0; i < 34; ++i) acc[i] = 0.f;
        for (int k = ks; k < 1024; k += 4) {
            const float wv = w[(size_t)k * 6144];
            const f32x4* s4 = (const f32x4*)(SC + k * 36);
#pragma unroll
            for (int q = 0; q < 8; ++q) { const f32x4 s = s4[q]; acc[4 * q] += s[0] * wv; acc[4 * q + 1] += s[1] * wv; acc[4 * q + 2] += s[2] * wv; acc[4 * q + 3] += s[3] * wv; }
            { const f32x4 s = s4[8]; acc[32] += s[0] * wv; acc[33] += s[1] * wv; }
        }
#pragma unroll
        for (int i = 0; i < 34; ++i) { float a = acc[i]; a += __shfl_xor(a, 16); a += __shfl_xor(a, 32); acc[i] = a; }
        if (ks == 0) { const float bb = P.ada_b[l * 6144 + n];
#pragma unroll
            for (int i = 0; i < 34; ++i) MOD[((size_t)l * 34 + i) * 6144 + n] = acc[i] + bb; }
    }
    __syncthreads();
}

template <bool FINAL>
__device__ __forceinline__ void job_norm(const Params& P, const Ctx& C0, int l, int idx) { unsigned char* const wsb = launder(P.ws); const Ctx C = relaunder(C0);
    const float* X = (const float*)(wsb + WS_X); bf16* H = (bf16*)(wsb + WS_H); const float* MOD = (const float*)(wsb + WS_MOD);
    const int gw = C.bid * NWAVES + C.wave, NGW = C.G * NWAVES;
    const float* g = FINAL ? P.final_g : P.norm_g + (size_t)(l * 2 + idx) * DM;
    for (int r = gw; r < (FINAL ? MV : MT); r += NGW) {
        if (!FINAL && r >= MV) { u32x2* o = (u32x2*)(H + (size_t)r * DM) + C.lane;
#pragma unroll
            for (int i = 0; i < 4; ++i) o[64 * i] = (u32x2){0u, 0u};
            continue; }
        const f32x4* xr = (const f32x4*)(X + (size_t)r * DM) + C.lane;
        f32x4 v[4]; float s = 0.f;
#pragma unroll
        for (int i = 0; i < 4; ++i) { v[i] = xr[64 * i]; s += (v[i][0] * v[i][0] + v[i][1] * v[i][1]) + (v[i][2] * v[i][2] + v[i][3] * v[i][3]); }
        const float rstd = rsqrtf(wave_sum(s) * (1.f / DM) + EPSN);
        if (FINAL) { f32x4* o = (f32x4*)(P.out + (r < MP ? O_YP + (size_t)r * DM : O_YS + (size_t)(r - MP) * DM)) + C.lane;
#pragma unroll
            for (int i = 0; i < 4; ++i) { const f32x4 gv = ((const f32x4*)g)[C.lane + 64 * i]; o[64 * i] = v[i] * rstd * gv; } }
        else { const float* mr = MOD + ((size_t)l * 34 + mbidx(r)) * 6144; const f32x4* sh = (const f32x4*)(mr + (idx ? 3 : 0) * DM) + C.lane; const f32x4* sc = (const f32x4*)(mr + (idx ? 4 : 1) * DM) + C.lane;
            u32x2* o = (u32x2*)(H + (size_t)r * DM) + C.lane;
#pragma unroll
            for (int i = 0; i < 4; ++i) { const f32x4 gv = ((const f32x4*)g)[C.lane + 64 * i]; const f32x4 y = v[i] * rstd * gv * (sc[64 * i] + 1.f) + sh[64 * i]; o[64 * i] = (u32x2){pk2(y[0], y[1]), pk2(y[2], y[3])}; } }
    }
}

template <bool SAMPLE>
__device__ __forceinline__ void job_compress1(const Params& P, const Ctx& C0, int j) { unsigned char* const wsb = launder(P.ws); const Ctx C = relaunder(C0);
    const int NB = SAMPLE ? 32 : 2, ntile = 2 * NB * 512 * 2 / 64;
    const bf16* Z = (const bf16*)(wsb + WS_Z);
    float* A01 = SAMPLE ? (float*)(wsb + WS_A01S) + (size_t)j * 65536 * 128 : (float*)(wsb + WS_A01P);
    for (int tl = C.bid; tl < ntile; tl += C.G) {
        const int row0 = tl * 64, type = row0 / (NB * 1024);
        const bf16* W = (const bf16*)(wsb + WS_WPHI) + (size_t)(j * 2 + type) * 128 * 1024;
        auto la = [&](int r, int k) -> bf16x8 {
            const int row = row0 + r, g = row & 1, i = (row >> 1) & 511, b = (row >> 10) % NB, p = k >> 6, d = k & 63, pos = i * 16 + p;
            if (SAMPLE) { const int page = P.page_table[b * 64 + (pos >> 7)];
                const float* src = P.cache + ((((size_t)j * NPOOL + page) * 128 + (pos & 127)) * 4 + type) * 128 + g * 64 + d;
                const f32x4 a = *(const f32x4*)src, c = *(const f32x4*)(src + 4);
                u32x4 w; w.x = pk2(a[0], a[1]); w.y = pk2(a[2], a[3]); w.z = pk2(c[0], c[1]); w.w = pk2(c[2], c[3]); return __builtin_bit_cast(bf16x8, w); }
            else return *(const bf16x8*)(Z + (size_t)(b * SEQ + pos) * NABP + C_KV + type * 128 + g * 64 + d);
        };
        auto lb = [&](int n, int k) -> bf16x8 { return *(const bf16x8*)(W + (size_t)n * 1024 + k); };
        auto ep = [&](int r, int c, f32x4 v) { *(f32x4*)(A01 + (size_t)(row0 + r) * 128 + c) = v; };
        tile_gemm_64x128(C.lds, C.tid, 1024, la, lb, ep);
    }
}
template <bool SAMPLE>
__device__ __forceinline__ void job_compress2(const Params& P, const Ctx& C0, int j) { unsigned char* const wsb = launder(P.ws); const Ctx C = relaunder(C0);
    const int NB = SAMPLE ? 32 : 2, nrow = 2 * NB * 511 * 2;
    const float* A01 = SAMPLE ? (const float*)(wsb + WS_A01S) + (size_t)j * 65536 * 128 : (const float*)(wsb + WS_A01P);
    float* KC = SAMPLE ? (float*)(wsb + WS_KCS) + (size_t)j * 2 * 32 * 512 * 128 : (float*)(wsb + WS_KC);
    const float* PEC = (const float*)(wsb + WS_PEC);
    const int gw = C.bid * NWAVES + C.wave, NGW = C.G * NWAVES;
    for (int u = gw; u < nrow; u += NGW) {
        const int g = u & 1, n = (u >> 1) % 511, tb = (u >> 1) / 511, type = tb / NB, b = tb % NB;
        const size_t r0 = ((size_t)(type * NB + b) * 512 + n) * 2 + g;
        const float pre = PEC[(j * 2 + type) * 64 + C.lane] + A01[r0 * 128 + C.lane] + A01[(r0 + 2) * 128 + 64 + C.lane];
        const float hid = gelu_tanh(pre);
        const float* w2 = P.phi_w2 + (size_t)(j * 2 + type) * 4096;
        float a = P.phi_b2[(j * 2 + type) * 64 + C.lane];
#pragma unroll 8
        for (int hc = 0; hc < 64; ++hc) a += __shfl(hid, hc) * w2[hc * 64 + C.lane];
        KC[r0 * 64 + C.lane] = a;
    }
}

__device__ __forceinline__ void job_mlstm_local(const Params& P, const Ctx& C0, int j) { unsigned char* const wsb = launder(P.ws); const Ctx C = relaunder(C0);
    const bf16* Z = (const bf16*)(wsb + WS_Z); const float* GT = (const float*)(wsb + WS_GATE); bf16* QK = (bf16*)(wsb + WS_QK);
    float* G = (float*)(wsb + WS_G); float* NU = (float*)(wsb + WS_NU); float* CHK = (float*)(wsb + WS_CHK);
    float* kf = (float*)C.lds; float* vf = kf + 64 * 128; float* wts = vf + 64 * 128;
    const int tid = C.tid;
    for (int u = C.bid; u < 1024; u += C.G) {
        const int bh = u >> 7, c = u & 127, b = bh >> 2, h = bh & 3, r0 = b * SEQ + c * 64;
        __syncthreads();
        if (C.wave == 0) {
            const int t = C.lane; const float li = GT[(size_t)(r0 + t) * 8 + h]; const float lf = logsigmoidf_(GT[(size_t)(r0 + t) * 8 + 4 + h] + P.ml_f_bias[j * 4 + h]);
            float bt = lf;
#pragma unroll
            for (int o = 1; o < 64; o <<= 1) { const float y = __shfl_up(bt, o); if (t >= o) bt += y; }
            const float bl = __shfl(bt, 63), gs = bl - bt + li, gm = wave_max(gs);
            wts[t] = __expf(gs - gm);
            if (t == 0) { CHK[u * 4] = bl; CHK[u * 4 + 1] = gm; }
        }
        {
            const int cc = tid & 255, t0 = (tid >> 8) * 32, col = cc < 128 ? h * 128 + cc : 512 + h * 128 + (cc - 128);
            const float* cw = P.ml_conv_w + (size_t)j * 4 * 1024 + col; const float w0 = cw[0], w1 = cw[1024], w2 = cw[2048], w3 = cw[3072], cb = P.ml_conv_b[j * 1024 + col];
            float x0, x1, x2;
            { const int tg = c * 64 + t0; const bf16* zp = Z + (size_t)(r0 + t0) * NABP + col;
              x0 = tg >= 3 ? bf2f(*(zp - 3 * NABP)) : 0.f; x1 = tg >= 2 ? bf2f(*(zp - 2 * NABP)) : 0.f; x2 = tg >= 1 ? bf2f(*(zp - NABP)) : 0.f; }
#pragma unroll 4
            for (int i = 0; i < 32; ++i) { const int t = t0 + i; const float x3 = bf2f(Z[(size_t)(r0 + t) * NABP + col]);
                const float y = cb + w0 * x0 + w1 * x1 + w2 * x2 + w3 * x3; float s = siluf_(y); if (cc >= 128) s *= 0.08838834764831845f;
                const unsigned hb = f2bf(s); QK[(size_t)(r0 + t) * 1024 + col] = (bf16)hb; if (cc >= 128) kf[t * 128 + (cc - 128)] = bf2f(hb);
                x0 = x1; x1 = x2; x2 = x3; }
            for (int i = tid; i < 64 * 128; i += NTHR) { const int t = i >> 7, e = i & 127; vf[i] = bf2f(Z[(size_t)(r0 + t) * NABP + C_V + h * 128 + e]); }
        }
        __syncthreads();
        const int d0 = (tid >> 4) * 4, e0 = (tid & 15) * 8;
        float acc[4][8], nu[4];
#pragma unroll
        for (int a = 0; a < 4; ++a) { nu[a] = 0.f;
#pragma unroll
            for (int e = 0; e < 8; ++e) acc[a][e] = 0.f; }
        for (int s = 0; s < 64; ++s) {
            const float w = wts[s]; const f32x4 k4 = *(const f32x4*)(kf + s * 128 + d0) * w; const f32x4 va = *(const f32x4*)(vf + s * 128 + e0), vb = *(const f32x4*)(vf + s * 128 + e0 + 4);
#pragma unroll
            for (int a = 0; a < 4; ++a) { nu[a] += k4[a];
#pragma unroll
                for (int e = 0; e < 4; ++e) { acc[a][e] += k4[a] * va[e]; acc[a][4 + e] += k4[a] * vb[e]; } }
        }
#pragma unroll
        for (int a = 0; a < 4; ++a) { float* gp = G + ((size_t)u * 128 + d0 + a) * 128 + e0; *(f32x4*)gp = (f32x4){acc[a][0], acc[a][1], acc[a][2], acc[a][3]}; *(f32x4*)(gp + 4) = (f32x4){acc[a][4], acc[a][5], acc[a][6], acc[a][7]};
            if ((tid & 15) == 0) NU[u * 128 + d0 + a] = nu[a]; }
    }
    __syncthreads();
}

__device__ __forceinline__ void job_mlstm_scan(const Params& P, const Ctx& C0, int j) { unsigned char* const wsb = launder(P.ws); const Ctx C = relaunder(C0);
    const float* G = (const float*)(wsb + WS_G); const float* NU = (const float*)(wsb + WS_NU); const float* CHK = (const float*)(wsb + WS_CHK);
    float* CST = (float*)(wsb + WS_CST); float* NST = (float*)(wsb + WS_NST); float* MST = (float*)(wsb + WS_MST);
    float* dec = (float*)C.lds; float* scl = dec + 128; float* blv = scl + 128; float* gmv = blv + 128; float* mfin = gmv + 128;
    for (int u = C.bid; u < 8 * 33; u += C.G) {
        const int bh = u / 33, sl = u % 33, b = bh >> 2, h = bh & 3;
        __syncthreads();
        if (C.tid < 128) { blv[C.tid] = CHK[(bh * 128 + C.tid) * 4]; gmv[C.tid] = CHK[(bh * 128 + C.tid) * 4 + 1]; }
        __syncthreads();
        if (C.tid == 0) { float m = 0.f;
            for (int c = 0; c < 128; ++c) { const float mn = fmaxf(m + blv[c], gmv[c]); dec[c] = __expf(m + blv[c] - mn); scl[c] = __expf(gmv[c] - mn); if (sl == 0) MST[bh * 128 + c] = m; m = mn; }
            mfin[0] = m; if (sl == 0) P.out[O_PM + (j * 2 + b) * 4 + h] = m; }
        __syncthreads();
        if (sl < 32) { const int el = sl * 512 + C.tid; float cv = 0.f;
#pragma unroll 8
            for (int c = 0; c < 128; ++c) { const size_t o = ((size_t)(bh * 128 + c)) * 16384 + el; CST[o] = cv; cv = dec[c] * cv + scl[c] * G[o]; }
            P.out[O_PC + ((size_t)(j * 2 + b) * 4 + h) * 16384 + el] = cv; }
        else if (C.tid < 128) { float nv = 0.f;
            for (int c = 0; c < 128; ++c) { const size_t o = (size_t)(bh * 128 + c) * 128 + C.tid; NST[o] = nv; nv = dec[c] * nv + scl[c] * NU[o]; }
            P.out[O_PN + ((size_t)(j * 2 + b) * 4 + h) * 128 + C.tid] = nv; }
    }
    __syncthreads();
}

__device__ __forceinline__ void job_mlstm_out(const Params& P, const Ctx& C0, int j) { unsigned char* const wsb = launder(P.ws); const Ctx C = relaunder(C0);
    const bf16* Z = (const bf16*)(wsb + WS_Z); const float* GT = (const float*)(wsb + WS_GATE); const bf16* QK = (const bf16*)(wsb + WS_QK);
    const float* CST = (const float*)(wsb + WS_CST); const float* NST = (const float*)(wsb + WS_NST); const float* MST = (const float*)(wsb + WS_MST);
    bf16* MIX = (bf16*)(wsb + WS_MIX);
    bf16* qb = (bf16*)C.lds; bf16* kb = qb + 64 * 128; bf16* vb = kb + 64 * 128; float* Cl = (float*)(C.lds + 49152); float* S = (float*)(C.lds + 49152 + 65536);
    float* misc = (float*)(C.lds + 49152 + 65536 + 16384); float* btv = misc, *mtv = misc + 64, *wiv = misc + 128, *libv = misc + 192, *nvec = misc + 256, *qn = misc + 384;
    const int tid = C.tid;
    for (int u = C.bid; u < 1024; u += C.G) {
        const int bh = u >> 7, c = u & 127, b = bh >> 2, h = bh & 3, r0 = b * SEQ + c * 64;
        __syncthreads();
        if (C.wave == 0) {
            const int t = C.lane; const float li = GT[(size_t)(r0 + t) * 8 + h]; const float lf = logsigmoidf_(GT[(size_t)(r0 + t) * 8 + 4 + h] + P.ml_f_bias[j * 4 + h]);
            float bt = lf;
#pragma unroll
            for (int o = 1; o < 64; o <<= 1) { const float y = __shfl_up(bt, o); if (t >= o) bt += y; }
            float pm = li - bt;
#pragma unroll
            for (int o = 1; o < 64; o <<= 1) { const float y = __shfl_up(pm, o); if (t >= o) pm = fmaxf(pm, y); }
            const float m = MST[u], mt = bt + fmaxf(m, pm);
            btv[t] = bt; mtv[t] = mt; wiv[t] = __expf(m + bt - mt); libv[t] = li - bt;
        }
        for (int i = tid; i < 1024; i += NTHR) { const int t = i >> 4, ch = (i & 15) * 8;
            *(u32x4*)(qb + t * 128 + ch) = *(const u32x4*)(QK + (size_t)(r0 + t) * 1024 + h * 128 + ch);
            *(u32x4*)(kb + t * 128 + ch) = *(const u32x4*)(QK + (size_t)(r0 + t) * 1024 + 512 + h * 128 + ch);
            *(u32x4*)(vb + t * 128 + ch) = *(const u32x4*)(Z + (size_t)(r0 + t) * NABP + C_V + h * 128 + ch); }
        for (int i = tid; i < 4096; i += NTHR) ((f32x4*)Cl)[i] = ((const f32x4*)(CST + (size_t)u * 16384))[i];
        if (tid < 128) nvec[tid] = NST[u * 128 + tid];
        __syncthreads();
        {
            const int t = tid >> 3, s0 = (tid & 7) * 8; float dot[8]; float qnp = 0.f;
#pragma unroll
            for (int i = 0; i < 8; ++i) dot[i] = 0.f;
            for (int d8 = 0; d8 < 16; ++d8) { float q8[8]; unpack8(*(const u32x4*)(qb + t * 128 + d8 * 8), q8);
                if ((d8 >> 1) == (tid & 7)) {
#pragma unroll
                    for (int e = 0; e < 8; ++e) qnp += q8[e] * nvec[d8 * 8 + e]; }
#pragma unroll
                for (int i = 0; i < 8; ++i) { float k8[8]; unpack8(*(const u32x4*)(kb + (s0 + i) * 128 + d8 * 8), k8);
#pragma unroll
                    for (int e = 0; e < 8; ++e) dot[i] += q8[e] * k8[e]; } }
            qnp += __shfl_xor(qnp, 1); qnp += __shfl_xor(qnp, 2); qnp += __shfl_xor(qnp, 4);
            if ((tid & 7) == 0) qn[t] = qnp;
            const float bm = btv[t] - mtv[t];
#pragma unroll
            for (int i = 0; i < 8; ++i) { const int s = s0 + i; S[t * 64 + s] = s <= t ? dot[i] * __expf(bm + libv[s]) : 0.f; }
        }
        __syncthreads();
        {
            const int t = tid >> 3, e0 = (tid & 7) * 16; float acc[16], aci[16]; float rs = 0.f;
#pragma unroll
            for (int e = 0; e < 16; ++e) { acc[e] = 0.f; aci[e] = 0.f; }
            for (int s = 0; s <= t; ++s) { const float a = S[t * 64 + s]; rs += a; float v0[8], v1[8]; unpack8(*(const u32x4*)(vb + s * 128 + e0), v0); unpack8(*(const u32x4*)(vb + s * 128 + e0 + 8), v1);
#pragma unroll
                for (int e = 0; e < 8; ++e) { acc[e] += a * v0[e]; acc[8 + e] += a * v1[e]; } }
#pragma unroll 2
            for (int d = 0; d < 128; ++d) { const float a = bf2f(qb[t * 128 + d]); const f32x4* cp = (const f32x4*)(Cl + d * 128 + e0);
#pragma unroll
                for (int q = 0; q < 4; ++q) { const f32x4 cv = cp[q]; aci[4 * q] += a * cv[0]; aci[4 * q + 1] += a * cv[1]; aci[4 * q + 2] += a * cv[2]; aci[4 * q + 3] += a * cv[3]; } }
            const float wi = wiv[t], den = wi * qn[t] + rs, dn = 1.f / fmaxf(fabsf(den), __expf(-mtv[t]));
            float ss = 0.f;
#pragma unroll
            for (int e = 0; e < 16; ++e) { acc[e] = (wi * aci[e] + acc[e]) * dn; ss += acc[e] * acc[e]; }
            ss += __shfl_xor(ss, 1); ss += __shfl_xor(ss, 2); ss += __shfl_xor(ss, 4);
            const float rstd = rsqrtf(ss * (1.f / 128.f) + EPSN);
            const bf16* op = Z + (size_t)(r0 + t) * NABP + C_O + h * 128 + e0; const float* og = P.ml_out_g + j * 512 + h * 128 + e0;
            float o0[8], o1[8]; unpack8(*(const u32x4*)op, o0); unpack8(*(const u32x4*)(op + 8), o1);
            u32x4 w0, w1;
            float r[16];
#pragma unroll
            for (int e = 0; e < 8; ++e) { r[e] = acc[e] * rstd * og[e] * sigmoidf_(o0[e]); r[8 + e] = acc[8 + e] * rstd * og[8 + e] * sigmoidf_(o1[e]); }
            w0.x = pk2(r[0], r[1]); w0.y = pk2(r[2], r[3]); w0.z = pk2(r[4], r[5]); w0.w = pk2(r[6], r[7]); w1.x = pk2(r[8], r[9]); w1.y = pk2(r[10], r[11]); w1.z = pk2(r[12], r[13]); w1.w = pk2(r[14], r[15]);
            bf16* mp = MIX + (size_t)(r0 + t) * 1024 + h * 128 + e0; *(u32x4*)mp = w0; *(u32x4*)(mp + 8) = w1;
        }
    }
    __syncthreads();
}

__device__ __forceinline__ void job_mlstm_sample(const Params& P, const Ctx& C0, int j) { unsigned char* const wsb = launder(P.ws); const Ctx C = relaunder(C0);
    const bf16* Z = (const bf16*)(wsb + WS_Z); const float* GT = (const float*)(wsb + WS_GATE); bf16* MIX = (bf16*)(wsb + WS_MIX);
    float* qf = (float*)C.lds; float* kf = qf + 512; float* vf = kf + 512; float* hb = vf + 512; float* S = hb + 512; float* sc = S + 16;
    const int tid = C.tid;
    for (int u = C.bid; u < 128; u += C.G) {
        const int sb = u >> 2, h = u & 3, r0 = MP + sb * 4;
        const float* C0 = P.st_C + ((size_t)(j * 32 + sb) * 4 + h) * 16384; const float* n0 = P.st_n + ((size_t)(j * 32 + sb) * 4 + h) * 128;
        __syncthreads();
        if (tid == 0) {
            const float m0 = P.st_m[(j * 32 + sb) * 4 + h]; float bt[4], li[4], pm = -INFINITY, b = 0.f;
#pragma unroll
            for (int t = 0; t < 4; ++t) { li[t] = GT[(size_t)(r0 + t) * 8 + h]; b += logsigmoidf_(GT[(size_t)(r0 + t) * 8 + 4 + h] + P.ml_f_bias[j * 4 + h]); bt[t] = b;
                pm = fmaxf(pm, li[t] - b); const float mt = b + fmaxf(m0, pm); sc[t] = b; sc[4 + t] = mt; sc[8 + t] = __expf(m0 + b - mt); }
            float gm = -INFINITY;
#pragma unroll
            for (int t = 0; t < 4; ++t) gm = fmaxf(gm, bt[3] - bt[t] + li[t]);
            const float mn = fmaxf(m0 + bt[3], gm);
#pragma unroll
            for (int t = 0; t < 4; ++t) { sc[12 + t] = __expf(bt[3] - bt[t] + li[t] - mn); sc[24 + t] = li[t] - bt[t]; }
            sc[20] = __expf(m0 + bt[3] - mn); P.out[O_SM + (j * 32 + sb) * 4 + h] = mn;
        }
        {
            const int cc = tid & 255, col = cc < 128 ? h * 128 + cc : 512 + h * 128 + (cc - 128);
            const float* cw = P.ml_conv_w + (size_t)j * 4 * 1024 + col; const float w0 = cw[0], w1 = cw[1024], w2 = cw[2048], w3 = cw[3072], cb = P.ml_conv_b[j * 1024 + col];
            const float* cbuf = P.st_conv + (size_t)(j * 32 + sb) * 3 * 1024 + col;
            float xs[7];
#pragma unroll
            for (int i = 0; i < 3; ++i) xs[i] = cbuf[i * 1024];
#pragma unroll
            for (int i = 0; i < 4; ++i) xs[3 + i] = bf2f(Z[(size_t)(r0 + i) * NABP + col]);
#pragma unroll
            for (int q = 0; q < 2; ++q) { const int t = (tid >> 8) * 2 + q;
                float y = cb;
                if (t == 0) y += w0 * xs[0] + w1 * xs[1] + w2 * xs[2] + w3 * xs[3]; else if (t == 1) y += w0 * xs[1] + w1 * xs[2] + w2 * xs[3] + w3 * xs[4];
                else if (t == 2) y += w0 * xs[2] + w1 * xs[3] + w2 * xs[4] + w3 * xs[5]; else y += w0 * xs[3] + w1 * xs[4] + w2 * xs[5] + w3 * xs[6];
                float s = siluf_(y); if (cc >= 128) { s *= 0.08838834764831845f; kf[t * 128 + cc - 128] = s; } else qf[t * 128 + cc] = s; }
            { const int t = tid >> 7, e = tid & 127; vf[tid] = bf2f(Z[(size_t)(r0 + t) * NABP + C_V + h * 128 + e]); }
        }
        __syncthreads();
        if (tid < 16) { const int t = tid >> 2, s = tid & 3; float d = 0.f; for (int k = 0; k < 128; ++k) d += qf[t * 128 + k] * kf[s * 128 + k];
            S[tid] = s <= t ? d * __expf(sc[t] - sc[4 + t] + sc[24 + s]) : 0.f; }
        else if (tid >= 64 && tid < 68) { const int t = tid - 64; float d = 0.f; for (int k = 0; k < 128; ++k) d += qf[t * 128 + k] * n0[k]; sc[16 + t] = d; }
        __syncthreads();
        { const int t = tid >> 7, e = tid & 127; float ai = 0.f;
            for (int d = 0; d < 128; ++d) ai += qf[t * 128 + d] * C0[d * 128 + e];
            float a = 0.f, rs = 0.f;
#pragma unroll
            for (int s = 0; s < 4; ++s) { a += S[t * 4 + s] * vf[s * 128 + e]; rs += S[t * 4 + s]; }
            const float wi = sc[8 + t], den = wi * sc[16 + t] + rs;
            hb[tid] = (wi * ai + a) / fmaxf(fabsf(den), __expf(-sc[4 + t])); }
        __syncthreads();
        { const int t = tid >> 7, e = tid & 127; float ss = 0.f; for (int k = 0; k < 128; ++k) ss += hb[t * 128 + k] * hb[t * 128 + k];
            const float rstd = rsqrtf(ss * (1.f / 128.f) + EPSN), o = bf2f(Z[(size_t)(r0 + t) * NABP + C_O + h * 128 + e]);
            MIX[(size_t)(r0 + t) * 1024 + h * 128 + e] = (bf16)f2bf(hb[tid] * rstd * P.ml_out_g[j * 512 + h * 128 + e] * sigmoidf_(o)); }
        { const float decay = sc[20]; float* Co = P.out + O_SC + ((size_t)(j * 32 + sb) * 4 + h) * 16384;
            for (int i = 0; i < 32; ++i) { const int idx = i * 512 + tid, d = idx >> 7, e = idx & 127; float a = decay * C0[idx];
#pragma unroll
                for (int s = 0; s < 4; ++s) a += sc[12 + s] * kf[s * 128 + d] * vf[s * 128 + e];
                Co[idx] = a; }
            if (tid < 128) { float a = decay * n0[tid];
#pragma unroll
                for (int s = 0; s < 4; ++s) a += sc[12 + s] * kf[s * 128 + tid];
                P.out[O_SN + ((size_t)(j * 32 + sb) * 4 + h) * 128 + tid] = a; } }
    }
    __syncthreads();
}

struct KeyRef { const void* k; const void* v; bool valid; };
template <bool F32>
__device__ __forceinline__ void load8f(const void* p, int off, float (&o)[8]) {
    if (F32) { const f32x4 a = *(const f32x4*)((const float*)p + off), b = *(const f32x4*)((const float*)p + off + 4); o[0] = a[0]; o[1] = a[1]; o[2] = a[2]; o[3] = a[3]; o[4] = b[0]; o[5] = b[1]; o[6] = b[2]; o[7] = b[3]; }
    else unpack8(*(const u32x4*)((const bf16*)p + off), o);
}
template <bool F32, class KF>
__device__ __forceinline__ void attn_branch(const KF& kf, int nk, const f32x4* qs, f32x4* sc, int lane, float (&o)[4], float (&inv)[4]) {
    float mx[4] = {-INFINITY, -INFINITY, -INFINITY, -INFINITY};
    for (int c0 = 0; c0 < nk; c0 += 64) {
        const int idx = c0 + lane; KeyRef kr; kr.valid = false; kr.k = nullptr; kr.v = nullptr;
        if (idx < nk) kr = kf(idx);
        float s[4] = {-INFINITY, -INFINITY, -INFINITY, -INFINITY};
        if (kr.valid) { s[0] = s[1] = s[2] = s[3] = 0.f;
#pragma unroll 2
            for (int d8 = 0; d8 < 8; ++d8) { float kk[8]; load8f<F32>(kr.k, d8 * 8, kk);
#pragma unroll
                for (int i = 0; i < 8; ++i) { const f32x4 q4 = qs[d8 * 8 + i]; s[0] += kk[i] * q4[0]; s[1] += kk[i] * q4[1]; s[2] += kk[i] * q4[2]; s[3] += kk[i] * q4[3]; } } }
        sc[idx] = (f32x4){s[0], s[1], s[2], s[3]};
#pragma unroll
        for (int r = 0; r < 4; ++r) mx[r] = fmaxf(mx[r], s[r]);
    }
    float sum[4] = {0.f, 0.f, 0.f, 0.f};
#pragma unroll
    for (int r = 0; r < 4; ++r) { mx[r] = wave_max(mx[r]); if (mx[r] == -INFINITY) mx[r] = 0.f; }
    for (int c0 = 0; c0 < nk; c0 += 64) { const int idx = c0 + lane; f32x4 s = sc[idx];
#pragma unroll
        for (int r = 0; r < 4; ++r) { s[r] = __expf(s[r] - mx[r]); sum[r] += s[r]; }
        sc[idx] = s; }
#pragma unroll
    for (int r = 0; r < 4; ++r) { sum[r] = wave_sum(sum[r]); inv[r] = sum[r] > 0.f ? 1.f / sum[r] : 1.f; o[r] = 0.f; }
    asm volatile("s_waitcnt lgkmcnt(0)" ::: "memory");
#pragma unroll 4
    for (int jj = 0; jj < nk; ++jj) {
        const KeyRef kr = kf(jj);
        if (!kr.valid) continue;
        const f32x4 p = sc[jj];
        const float vv = F32 ? ((const float*)kr.v)[lane] : bf2f(((const bf16*)kr.v)[lane]);
        o[0] += p[0] * vv; o[1] += p[1] * vv; o[2] += p[2] * vv; o[3] += p[3] * vv;
    }
#pragma unroll
    for (int r = 0; r < 4; ++r) o[r] *= inv[r];
}

__device__ __forceinline__ int nsa_select(const f32x4* sc, const float (&inv)[4], int ncv, int cur, int* sel, int lane) {
    float c[2];
#pragma unroll
    for (int q = 0; q < 2; ++q) { const int jb = lane + 64 * q; float a = 0.f;
        for (int n = 4 * jb - 1; n <= 4 * jb + 3; ++n) if (n >= 0 && n < ncv) { const f32x4 p = sc[n]; a += p[0] * inv[0] + p[1] * inv[1] + p[2] * inv[2] + p[3] * inv[3]; }
        c[q] = (jb >= 1 && jb <= cur - 2) ? a : -1.f; }
    int cnt = 0;
    if (lane == 0) { sel[cnt] = 0; } cnt++;
    if (cur >= 1) { if (lane == 0) sel[cnt] = cur; cnt++; }
    if (cur >= 2) { if (lane == 0) sel[cnt] = cur - 1; cnt++; }
    const int nfree = 16 - cnt;
    for (int it = 0; it < nfree; ++it) {
        float bv = c[0]; int bi = lane; if (c[1] > bv) { bv = c[1]; bi = lane + 64; }
#pragma unroll
        for (int o = 1; o < 64; o <<= 1) { const float ov = __shfl_xor(bv, o); const int oi = __shfl_xor(bi, o); if (ov > bv || (ov == bv && oi < bi)) { bv = ov; bi = oi; } }
        if (bv < 0.f) break;
        if (lane == 0) sel[cnt] = bi;
        cnt++;
        if (bi == lane) c[0] = -2.f; if (bi == lane + 64) c[1] = -2.f;
    }
    asm volatile("s_waitcnt lgkmcnt(0)" ::: "memory");
    return cnt;
}

template <bool DEC>
__device__ __forceinline__ void job_nsa_naive(const Params& P, const Ctx& C0, int j) { unsigned char* const wsb = launder(P.ws); const Ctx C = relaunder(C0);
    const bf16* Z = (const bf16*)(wsb + WS_Z); bf16* MIX = (bf16*)(wsb + WS_MIX);
    const float* KC = DEC ? (const float*)(wsb + WS_KCS) + (size_t)j * 2 * 32 * 512 * 128 : (const float*)(wsb + WS_KC);
    const int NB = DEC ? 32 : 2;
    const float* VC = KC + (size_t)NB * 512 * 128;
    f32x4* qs = (f32x4*)(C.lds + C.wave * 17664); f32x4* sc = qs + 64; int* sel = (int*)(sc + 1024 + 8);
    const int lane = C.lane, gw = C.bid * NWAVES + C.wave, NGW = C.G * NWAVES;
    const int nunit = DEC ? 32 * 4 * 2 : MP * 2;
    for (int u = gw; u < nunit; u += NGW) {
        const int g = u & 1, bt_ = u >> 1, b = DEC ? (bt_ >> 2) : (bt_ >> 13), t = DEC ? (bt_ & 3) : (bt_ & 8191);
        const int row = DEC ? MP + bt_ : bt_, qpos = DEC ? SEQ + t : t;
        const bf16* zr = Z + (size_t)row * NABP;
        { f32x4 q4;
#pragma unroll
          for (int r = 0; r < 4; ++r) q4[r] = bf2f(zr[C_QN + (g * 4 + r) * 64 + lane]) * 0.125f;
          qs[lane] = q4; }
        asm volatile("s_waitcnt lgkmcnt(0)" ::: "memory");
        float gt[4][3];
#pragma unroll
        for (int r = 0; r < 4; ++r)
#pragma unroll
            for (int q = 0; q < 3; ++q) gt[r][q] = sigmoidf_(bf2f(zr[C_GN + (g * 4 + r) * 3 + q]));
        float oc[4], os[4], ow[4], inv[4];
        const int ncv = DEC ? 511 : (qpos >= 31 ? (((qpos - 31) >> 4) + 1 > 511 ? 511 : ((qpos - 31) >> 4) + 1) : 0);
        { auto kf = [&](int idx) -> KeyRef { KeyRef k; const size_t o = ((size_t)(b * 512 + idx) * 2 + g) * 64; k.k = KC + o; k.v = VC + o; k.valid = idx < ncv; return k; };
          attn_branch<true>(kf, ncv, qs, sc, lane, oc, inv); }
        const int cur = qpos >> 6;
        const int nsel = nsa_select(sc, inv, ncv, cur, sel, lane);
        { auto kf = [&](int idx) -> KeyRef { KeyRef k; const int blk = sel[idx >> 6], pos = blk * 64 + (idx & 63); k.valid = pos <= qpos;
              if (DEC) { const float* base;
                  if (pos < SEQ) { const int page = P.page_table[b * 64 + (pos >> 7)]; base = P.cache + ((((size_t)j * NPOOL + page) * 128 + (pos & 127)) * 4 + 2) * 128 + g * 64; }
                  else base = P.out + O_SKV + (((size_t)(j * 32 + b) * 4 + (pos - SEQ > 3 ? 3 : pos - SEQ)) * 4 + 2) * 128 + g * 64;
                  k.k = base; k.v = base + 128; }
              else { const bf16* base = Z + (size_t)(b * SEQ + pos) * NABP + C_KV + 256 + g * 64; k.k = base; k.v = base + 128; }
              return k; };
          attn_branch<DEC>(kf, nsel * 64, qs, sc, lane, os, inv); }
        { auto kf = [&](int idx) -> KeyRef { KeyRef k;
              if (DEC) { k.valid = idx >= t && idx <= 512 + t;
                  const float* base = idx < 4 ? P.st_win + (((size_t)(j * 32 + b) * 512 + idx) * 2) * 128 + g * 64 : P.out + O_SWIN + (((size_t)(j * 32 + b) * 512 + (idx - 4)) * 2) * 128 + g * 64;
                  k.k = base; k.v = base + 128; }
              else { const int pos = qpos - 512 + idx; k.valid = pos >= 0; const bf16* base = Z + (size_t)(b * SEQ + (pos < 0 ? 0 : pos)) * NABP + C_WIN + g * 64; k.k = base; k.v = base + 128; }
              return k; };
          attn_branch<DEC>(kf, DEC ? 516 : 513, qs, sc, lane, ow, inv); }
#pragma unroll
        for (int r = 0; r < 4; ++r) MIX[(size_t)row * 1024 + 512 + (g * 4 + r) * 64 + lane] = (bf16)f2bf(gt[r][0] * oc[r] + gt[r][1] * os[r] + gt[r][2] * ow[r]);
    }
}

__device__ __forceinline__ void job_gate_prompt(const Params& P, const Ctx& C0, int jc) { unsigned char* const wsb = launder(P.ws); const Ctx C = relaunder(C0);
    const bf16* Z2 = (const bf16*)(wsb + WS_Z); bf16* MIX = (bf16*)(wsb + WS_MIX);
    bf16* vh = (bf16*)C.lds;
    float* wsl = (float*)(C.lds + 65536);
    float* rstd = (float*)(C.lds + 131072);
    const int tid = C.tid;
    for (int u = C.bid; u < 512; u += C.G) {
        const int ch = u >> 2, gq = u & 3, r0 = ch * 128;
        __syncthreads();
        for (int rr = C.wave; rr < 128; rr += NWAVES) { const bf16* vr = Z2 + (size_t)(r0 + rr) * 2048 + 1024; float a[8], b[8]; unpack8(*(const u32x4*)(vr + C.lane * 16), a); unpack8(*(const u32x4*)(vr + C.lane * 16 + 8), b);
            float s = 0.f;
#pragma unroll
            for (int e = 0; e < 8; ++e) s += a[e] * a[e] + b[e] * b[e];
            s = wave_sum(s); if (C.lane == 0) rstd[rr] = rsqrtf(s * (1.f / 1024.f) + EPSN); }
        for (int i = tid; i < 4096; i += NTHR) ((f32x4*)wsl)[i] = ((const f32x4*)(P.cl_ws + (size_t)(jc * 4 + gq) * 16384))[i];
        __syncthreads();
        for (int i = tid; i < 128 * 32; i += NTHR) { const int s = i >> 5, d0 = (i & 31) * 8; float a[8]; unpack8(*(const u32x4*)(Z2 + (size_t)(r0 + s) * 2048 + 1024 + gq * 256 + d0), a);
            const float rs = rstd[s]; const float* gv = P.cl_v_g + jc * 1024 + gq * 256 + d0; u32x4 w;
            w.x = pk2(a[0] * rs * gv[0], a[1] * rs * gv[1]); w.y = pk2(a[2] * rs * gv[2], a[3] * rs * gv[3]); w.z = pk2(a[4] * rs * gv[4], a[5] * rs * gv[5]); w.w = pk2(a[6] * rs * gv[6], a[7] * rs * gv[7]);
            *(u32x4*)(vh + s * 256 + d0) = w; }
        __syncthreads();
        const int t0 = (tid >> 5) * 8, d0 = (tid & 31) * 8;
        float acc[8][8];
#pragma unroll
        for (int a = 0; a < 8; ++a)
#pragma unroll
            for (int e = 0; e < 8; ++e) acc[a][e] = 0.f;
        for (int s = 0; s < t0 + 8; ++s) { float v8[8]; unpack8(*(const u32x4*)(vh + s * 256 + d0), v8);
#pragma unroll
            for (int a = 0; a < 8; ++a) { const float w = (s <= t0 + a) ? wsl[(t0 + a) * 128 + s] : 0.f;
#pragma unroll
                for (int e = 0; e < 8; ++e) acc[a][e] += w * v8[e]; } }
#pragma unroll
        for (int a = 0; a < 8; ++a) { const int t = t0 + a; const float bs = P.cl_bs[(jc * 4 + gq) * 128 + t]; float uu[8]; unpack8(*(const u32x4*)(Z2 + (size_t)(r0 + t) * 2048 + gq * 256 + d0), uu);
            u32x4 w; w.x = pk2(uu[0] * (acc[a][0] + bs), uu[1] * (acc[a][1] + bs)); w.y = pk2(uu[2] * (acc[a][2] + bs), uu[3] * (acc[a][3] + bs));
            w.z = pk2(uu[4] * (acc[a][4] + bs), uu[5] * (acc[a][5] + bs)); w.w = pk2(uu[6] * (acc[a][6] + bs), uu[7] * (acc[a][7] + bs));
            *(u32x4*)(MIX + (size_t)(r0 + t) * 1024 + gq * 256 + d0) = w; }
    }
    __syncthreads();
}
__device__ __forceinline__ void job_gate_sample(const Params& P, const Ctx& C0, int jc) { unsigned char* const wsb = launder(P.ws); const Ctx C = relaunder(C0);
    const bf16* Z2 = (const bf16*)(wsb + WS_Z); bf16* MIX = (bf16*)(wsb + WS_MIX);
    float* vh = (float*)C.lds; float* red = vh + 4096;
    const int tid = C.tid;
    for (int u = C.bid; u < 32; u += C.G) {
        const int r0 = MP + u * 4;
        __syncthreads();
        float v[8];
#pragma unroll
        for (int i = 0; i < 8; ++i) { const int idx = i * 512 + tid, t = idx >> 10, c = idx & 1023; v[i] = bf2f(Z2[(size_t)(r0 + t) * 2048 + 1024 + c]); }
#pragma unroll
        for (int t = 0; t < 4; ++t) { float s = v[2 * t] * v[2 * t] + v[2 * t + 1] * v[2 * t + 1]; s = wave_sum(s); if (C.lane == 0) red[t * 8 + C.wave] = s; }
        __syncthreads();
#pragma unroll
        for (int i = 0; i < 8; ++i) { const int idx = i * 512 + tid, t = idx >> 10, c = idx & 1023; float s = 0.f;
#pragma unroll
            for (int w = 0; w < 8; ++w) s += red[t * 8 + w];
            const float x = v[i] * rsqrtf(s * (1.f / 1024.f) + EPSN) * P.cl_v_g[jc * 1024 + c]; vh[idx] = x; P.out[O_SGV + ((size_t)(jc * 32 + u) * 4 + t) * 1024 + c] = x; }
        __syncthreads();
#pragma unroll
        for (int i = 0; i < 8; ++i) { const int idx = i * 512 + tid, t = idx >> 10, c = idx & 1023, gq = c >> 8; float s = P.cl_bs[(jc * 4 + gq) * 128 + t];
            for (int sp = 0; sp <= t; ++sp) s += P.cl_ws[(size_t)(jc * 4 + gq) * 16384 + t * 128 + sp] * vh[sp * 1024 + c];
            const float uu = bf2f(Z2[(size_t)(r0 + t) * 2048 + c]); MIX[(size_t)(r0 + t) * 1024 + c] = (bf16)f2bf(uu * s); }
    }
    __syncthreads();
}

#ifndef JOBMASK
#define JOBMASK 0xFFFFFFFFu
#endif
#define EN(n) ((JOBMASK >> (n)) & 1u)
__global__ void __launch_bounds__(NTHR, 2) trunk_fwd(Params P) {
    extern __shared__ __attribute__((aligned(16))) unsigned char lds[];
    Ctx C; C.lds = lds; C.tid = threadIdx.x; C.lane = C.tid & 63; C.wave = __builtin_amdgcn_readfirstlane(C.tid >> 6); C.bid = blockIdx.x; C.G = gridDim.x;
    volatile LAS unsigned* MISC = (volatile LAS unsigned*)((LAS unsigned char*)lds + MISC_OFF);
    if (C.tid < 64) MISC[C.tid] = 0u;
    __syncthreads();
    unsigned* ctl = (unsigned*)(P.ws + WS_CTL);
    const bool multi = (P.ph_hi - P.ph_lo) > 1;
    XcdBarrier bar; bar.bar = ctl + 4096; bar.x = 0; bar.st = nullptr;
    if (multi) bar = xcd_barrier_post(ctl + 4096, MISC + 8);
    const int lo = P.ph_lo, hi = P.ph_hi;
    int ph = 0;
#define IN() (lo <= ph && ph < hi)
#define SEAM() do { if (IN() && ph + 1 < hi) xcd_barrier(bar); ++ph; } while (0)
    LAS unsigned char* ldsl = (LAS unsigned char*)lds;

    if (IN()) { if(EN(0)) job_transposes(P, C); if(EN(1)) job_copy_x(P, C); if(EN(2)) job_adaln(P, C); }
    SEAM();
    if (IN()) { if(EN(3)) job_norm<false>(P, C, 0, 0); if(EN(4)) { job_compress1<true>(P, C, 0); job_compress1<true>(P, C, 1); } }
    SEAM();
    for (int l = 0; l < 4; ++l) {
        const int j = l >> 1;
        if ((l & 1) == 0) {
            if (IN()) { unsigned char* ws = launder(P.ws); pg8::Gemm g{(const bf16*)(ws + WS_H), (const bf16*)(ws + WS_WABIN) + (size_t)j * NABP * DM, MT, NABP, DM}; pg8::StaticOrder S; S.init(MT, NABP, C.G, C.bid);
                pg8::EpiAbIn E{(bf16*)(ws + WS_Z), P.ab_b_in + (size_t)j * NABV, (float*)(ws + WS_GATE), P.out, j};
                if(EN(16)) pg8::gemm_phase<pg8::EpiAbIn, pg8::StaticOrder, true, true>(ldsl, g, S, E); }
            SEAM();
            if (IN()) { if(EN(5)) job_mlstm_local(P, C, j); if(EN(4)) job_compress1<false>(P, C, j); if(EN(6)) job_mlstm_sample(P, C, j); if(EN(7)) job_compress2<true>(P, C, j); }
            SEAM();
            if (IN()) { if(EN(8)) job_mlstm_scan(P, C, j); if(EN(7)) job_compress2<false>(P, C, j); }
            SEAM();
            if (IN()) { if(EN(9)) job_mlstm_out(P, C, j); if(EN(10)) job_nsa_naive<false>(P, C, j); if(EN(11)) job_nsa_naive<true>(P, C, j); }
            SEAM();
        } else {
            if (IN()) { unsigned char* ws = launder(P.ws); pg8::Gemm g{(const bf16*)(ws + WS_H), (const bf16*)(ws + WS_WCLIN) + (size_t)j * 2048 * DM, MT, 2048, DM}; pg8::StaticOrder S; S.init(MT, 2048, C.G, C.bid);
                pg8::EpiAct<1> E{(bf16*)(ws + WS_Z), 2048, P.cl_b_in + (size_t)j * 2048};
                if(EN(17)) pg8::gemm_phase<pg8::EpiAct<1>, pg8::StaticOrder, true, true>(ldsl, g, S, E); }
            SEAM();
            if (IN()) { if(EN(12)) job_gate_prompt(P, C, j); if(EN(13)) job_gate_sample(P, C, j); }
            SEAM();
        }
        if (IN()) { unsigned char* ws = launder(P.ws); const bf16* Wt = (l & 1) ? (const bf16*)(ws + WS_WCLOUT) + (size_t)j * DM * DM : (const bf16*)(ws + WS_WABOUT) + (size_t)j * DM * DM;
            pg8::Gemm g{(const bf16*)(ws + WS_MIX), Wt, MT, DM, DM}; pg8::StaticOrder S; S.init(MT, DM, C.G, C.bid);
            pg8::EpiResid E{(float*)(ws + WS_X), (const float*)(ws + WS_MOD) + (size_t)l * 34 * 6144 + 2 * DM};
            if(EN(19)) pg8::gemm_phase<pg8::EpiResid, pg8::StaticOrder, true, true>(ldsl, g, S, E); }
        SEAM();
        if (IN()) { if(EN(3)) job_norm<false>(P, C, l, 1); }
        SEAM();
        if (IN()) { unsigned char* ws = launder(P.ws); pg8::Gemm g{(const bf16*)(ws + WS_H), (const bf16*)(ws + WS_WF1) + (size_t)l * FF * DM, MT, FF, DM}; pg8::StaticOrder S; S.init(MT, FF, C.G, C.bid);
            pg8::EpiAct<0> E{(bf16*)(ws + WS_ACT), FF, nullptr};
            if(EN(18)) pg8::gemm_phase<pg8::EpiAct<0>, pg8::StaticOrder, true, true>(ldsl, g, S, E); }
        SEAM();
        if (IN()) { unsigned char* ws = launder(P.ws); pg8::Gemm g{(const bf16*)(ws + WS_ACT), (const bf16*)(ws + WS_WF2) + (size_t)l * DM * FF, MT, DM, FF}; pg8::StaticOrder S; S.init(MT, DM, C.G, C.bid);
            pg8::EpiResid E{(float*)(ws + WS_X), (const float*)(ws + WS_MOD) + (size_t)l * 34 * 6144 + 5 * DM};
            if(EN(19)) pg8::gemm_phase<pg8::EpiResid, pg8::StaticOrder, true, true>(ldsl, g, S, E); }
        SEAM();
        if (IN()) { if(EN(3)) { if (l < 3) job_norm<false>(P, C, l + 1, 0); else job_norm<true>(P, C, 0, 0); } }
        SEAM();
    }
#undef IN
#undef SEAM
}
constexpr int N_PHASES = 2 + 2 * 9 + 2 * 7;

#ifndef MK_ONE_LAUNCH
#define MK_ONE_LAUNCH 1
#endif
extern "C" void kernel_launch(void* const* d_in, const int* in_sizes, int n_in, void* d_out, int out_size, void* d_ws, size_t ws_size, hipStream_t stream) {
    static int grid = 0;
    if (grid == 0) {
        if (n_in != 35 || out_size != (int)O_END || ws_size < WS_END) { fprintf(stderr, "kernel_launch: unexpected shapes (n_in %d out %d ws %zu)\n", n_in, out_size, ws_size); grid = -1; return; }
        int dev = 0, cus = 0, per_cu = 0;
        if (hipGetDevice(&dev) != hipSuccess || hipDeviceGetAttribute(&cus, hipDeviceAttributeMultiprocessorCount, dev) != hipSuccess) { grid = -1; return; }
        if (hipFuncSetAttribute((const void*)trunk_fwd, hipFuncAttributeMaxDynamicSharedMemorySize, LDS_BYTES) != hipSuccess) { fprintf(stderr, "kernel_launch: hipFuncSetAttribute failed\n"); grid = -1; return; }
        if (hipOccupancyMaxActiveBlocksPerMultiprocessor(&per_cu, (const void*)trunk_fwd, NTHR, LDS_BYTES) != hipSuccess || per_cu < 1) { fprintf(stderr, "kernel_launch: occupancy query says %d\n", per_cu); }
        (void)hipGetLastError();
        grid = cus;
    }
    if (grid < 0) return;
    (void)hipMemsetAsync((char*)d_ws + WS_CTL, 0, CTL_ZERO_BYTES, stream);
    Params p{};
    const float** fp = (const float**)&p.x_prompt;
    (void)fp;
    p.x_prompt = (const float*)d_in[0]; p.x_sample = (const float*)d_in[1]; p.c_prompt = (const float*)d_in[2]; p.c_sample = (const float*)d_in[3];
    p.st_conv = (const float*)d_in[4]; p.st_C = (const float*)d_in[5]; p.st_n = (const float*)d_in[6]; p.st_m = (const float*)d_in[7]; p.cache = (const float*)d_in[8]; p.st_win = (const float*)d_in[9];
    p.page_table = (const int*)d_in[10];
    p.ada_w = (const float*)d_in[11]; p.ada_b = (const float*)d_in[12]; p.norm_g = (const float*)d_in[13]; p.ab_w_in = (const float*)d_in[14]; p.ab_b_in = (const float*)d_in[15];
    p.ml_conv_w = (const float*)d_in[16]; p.ml_conv_b = (const float*)d_in[17]; p.ml_f_bias = (const float*)d_in[18]; p.ml_out_g = (const float*)d_in[19];
    p.phi_pe = (const float*)d_in[20]; p.phi_w1 = (const float*)d_in[21]; p.phi_b1 = (const float*)d_in[22]; p.phi_w2 = (const float*)d_in[23]; p.phi_b2 = (const float*)d_in[24];
    p.ab_w_out = (const float*)d_in[25]; p.cl_w_in = (const float*)d_in[26]; p.cl_b_in = (const float*)d_in[27]; p.cl_v_g = (const float*)d_in[28]; p.cl_ws = (const float*)d_in[29]; p.cl_bs = (const float*)d_in[30];
    p.cl_w_out = (const float*)d_in[31]; p.ffn_w1 = (const float*)d_in[32]; p.ffn_w2 = (const float*)d_in[33]; p.final_g = (const float*)d_in[34];
    p.out = (float*)d_out; p.ws = (unsigned char*)d_ws; p.pad = 0;
#if MK_ONE_LAUNCH
    p.ph_lo = 0; p.ph_hi = N_PHASES; p.li = 0;
    hipLaunchKernelGGL(trunk_fwd, dim3(grid), dim3(NTHR), LDS_BYTES, stream, p);
#else
    for (int k = 0; k < N_PHASES; ++k) { p.ph_lo = k; p.ph_hi = k + 1; p.li = k; hipLaunchKernelGGL(trunk_fwd, dim3(grid), dim3(NTHR), LDS_BYTES, stream, p); }
#endif
}
```

```cpp
#include <hip/hip_runtime.h>
#include <cstdio>
#include <cstdint>
namespace pg8 {
#define PG8_LAS __attribute__((address_space(3)))
typedef unsigned short bf16_t;
typedef short bf16x8 __attribute__((ext_vector_type(8)));
typedef float f32x4 __attribute__((ext_vector_type(4)));
typedef unsigned u32x4 __attribute__((ext_vector_type(4)));
constexpr int BM = 256, BK = 64, HALF = 128, HTB = HALF * BK * 2  , STAGE_BYTES = 8 * HTB, NXCD = 8, WGM = 8;

__host__ __device__ __forceinline__ int lds_byte(int r, int c) { const int st = (r >> 4) * 2 + (c >> 5), rr = r & 15, cc = c & 31, ob = rr * 64 + cc * 2; return st * 1024 + (ob ^ (((ob >> 9) & 1) << 5)); }
__host__ __device__ __forceinline__ void stage_rc(int b, int& R, int& C) { const int st = b / 1024, sb = b % 1024, swz = sb ^ (((sb >> 9) & 1) << 5); R = (st >> 1) * 16 + swz / 64; C = (st & 1) * 32 + (swz % 64) / 2; }
__host__ __device__ __forceinline__ int perm32(int rho) { const int n = rho >> 4, i = rho & 15; return 8 * (i >> 2) + 4 * n + (i & 3); }

struct Unit { int pm, pn; };
struct Gemm { const bf16_t* A; const bf16_t* Bt; int M, N, K; };

struct StaticOrder {
    int nM, nN, nwg, G, c;
    __host__ __device__ void init(int M, int N, int G_, int c_) { nM = M / BM; nN = N / BM; nwg = nM * nN; G = G_; c = c_; }
    __host__ __device__ bool next(int i, Unit& u) const {
        const long L = (long)i * G + c; if (L >= nwg) return false;
        int wgid = (int)L; { const int q = nwg / NXCD, r = nwg % NXCD, xcd = wgid % NXCD, off = wgid / NXCD; wgid = (xcd < r ? xcd * (q + 1) : r * (q + 1) + (xcd - r) * q) + off; }
        const int nig = WGM * nN, gid = wgid / nig, fm = gid * WGM, gsz = (nM - fm) < WGM ? (nM - fm) : WGM;
        u.pm = fm + ((wgid % nig) % gsz); u.pn = (wgid % nig) / gsz; return true;
    }
    __device__ __forceinline__ void a_ready(const Unit&) const {}
    __device__ __forceinline__ void done(const Unit&) const {}
};

__device__ __forceinline__ unsigned cvt_pk_bf16(float lo, float hi) { unsigned r; asm volatile("v_cvt_pk_bf16_f32 %0, %1, %2" : "=v"(r) : "v"(lo), "v"(hi)); return r; }
typedef float f32x2 __attribute__((ext_vector_type(2)));

template <class Epi, class Sched, bool ALIGN_EPI = false, bool SP2 = false>
__device__ __forceinline__ void gemm_phase(PG8_LAS unsigned char* lds, const Gemm g, const Sched& S, const Epi& E) {
    int tid_ = threadIdx.x; asm volatile("" : "+v"(tid_));
    const int tid = tid_, wid = __builtin_amdgcn_readfirstlane(tid >> 6), lane = tid & 63, wr = wid >> 2, wc = wid & 3, fr = lane & 15, fq = lane >> 4;
    const int K = g.K, nt = K / BK;
    unsigned voffA[2], voffB[2];
#pragma unroll
    for (int i = 0; i < 2; ++i) { int R, C; stage_rc(tid * 16 + i * 8192, R, C); const int Rb = Epi::PERM ? ((R & ~31) + perm32(R & 31)) : R;
        voffA[i] = (unsigned)(R * K + C) * 2u; voffB[i] = (unsigned)(Rb * K + C) * 2u; }
    const size_t kstep = (size_t)(BK * 2);
    const size_t hstep = (size_t)HALF * K * 2;
    const size_t tstep = 2 * hstep;
    const unsigned ldsw = (unsigned)wid * 1024u;
    const int aoff = lds_byte(wr * 64 + fr, fq * 8), boff = lds_byte(wc * 32 + fr, fq * 8);
#define PG8_SA(b, h) (((b) * 2 + (h)) * HTB)
#define PG8_SB(b, h) ((4 + (b) * 2 + (h)) * HTB)
#define PG8_STAGE(bufoff, gbase, voff) do { _Pragma("unroll") for (int _i = 0; _i < 2; ++_i) \
        __builtin_amdgcn_global_load_lds((const unsigned*)((const char*)(gbase) + (voff)[_i]), (PG8_LAS unsigned*)(lds + (bufoff) + ldsw + _i * 8192), 16, 0, 0); } while (0)
#define PG8_LDA(dst, b, h) do { _Pragma("unroll") for (int m = 0; m < 4; ++m) _Pragma("unroll") for (int k = 0; k < 2; ++k) dst[m][k] = *(const PG8_LAS bf16x8*)(lds + PG8_SA(b, h) + aoff + m * 2048 + k * 1024); } while (0)
#define PG8_LDB(dst, b, h) do { _Pragma("unroll") for (int n = 0; n < 2; ++n) _Pragma("unroll") for (int k = 0; k < 2; ++k) dst[n][k] = *(const PG8_LAS bf16x8*)(lds + PG8_SB(b, h) + boff + n * 2048 + k * 1024); } while (0)
#define PG8_MMA(ai, bj, At, Bt) do { __builtin_amdgcn_s_setprio(1); _Pragma("unroll") for (int m = 0; m < 4; ++m) _Pragma("unroll") for (int n = 0; n < 2; ++n) _Pragma("unroll") for (int k = 0; k < 2; ++k) \
        acc[ai][bj][m][n] = __builtin_amdgcn_mfma_f32_16x16x32_bf16(Bt[n][k], At[m][k], acc[ai][bj][m][n], 0, 0, 0); __builtin_amdgcn_s_setprio(0); } while (0)
#define PG8_WAIT_V(n) asm volatile("s_waitcnt vmcnt(" #n ")" ::: "memory")
#define PG8_WAIT_L(n) asm volatile("s_waitcnt lgkmcnt(" #n ")" ::: "memory")
#define PG8_BAR __builtin_amdgcn_s_barrier()
#define PG8_SCHED __builtin_amdgcn_sched_barrier(0)
    Unit cur, nxt; int ui = 0;
    if (!S.next(0, cur)) return;
    f32x4 acc[2][2][4][2];
#pragma unroll
    for (int a = 0; a < 2; ++a)
#pragma unroll
        for (int b = 0; b < 2; ++b)
#pragma unroll
            for (int m = 0; m < 4; ++m)
#pragma unroll
                for (int n = 0; n < 2; ++n) acc[a][b][m][n] = (f32x4){0.f, 0.f, 0.f, 0.f};
    bf16x8 At[4][2], B0[2][2], B1[2][2];
    const char* cA = (const char*)g.A + (size_t)cur.pm * tstep; const char* cB = (const char*)g.Bt + (size_t)cur.pn * tstep;
    S.a_ready(cur);
    if constexpr (SP2) {
        PG8_STAGE(PG8_SB(0, 0), cB, voffB); PG8_STAGE(PG8_SB(0, 1), cB + hstep, voffB); PG8_STAGE(PG8_SA(0, 0), cA, voffA); PG8_STAGE(PG8_SA(0, 1), cA + hstep, voffA);
        if (wr == 1) PG8_BAR;
        PG8_WAIT_V(2); PG8_BAR;
        PG8_STAGE(PG8_SB(1, 0), cB + kstep, voffB); PG8_STAGE(PG8_SA(1, 0), cA + kstep, voffA); PG8_STAGE(PG8_SB(1, 1), cB + hstep + kstep, voffB);
        PG8_WAIT_V(6); PG8_BAR;
    } else {
        PG8_STAGE(PG8_SB(0, 0), cB, voffB); PG8_STAGE(PG8_SA(0, 0), cA, voffA); PG8_STAGE(PG8_SB(0, 1), cB + hstep, voffB); PG8_STAGE(PG8_SA(0, 1), cA + hstep, voffA);
        if (wr == 1) PG8_BAR;
        PG8_WAIT_V(4); PG8_BAR;
        PG8_STAGE(PG8_SB(1, 0), cB + kstep, voffB); PG8_STAGE(PG8_SA(1, 0), cA + kstep, voffA); PG8_STAGE(PG8_SB(1, 1), cB + hstep + kstep, voffB);
        PG8_WAIT_V(6); PG8_BAR;
    }
    for (;;) {
        const bool has_next = S.next(ui + 1, nxt);
        const char* nA = has_next ? (const char*)g.A + (size_t)nxt.pm * tstep : cA; const char* nB = has_next ? (const char*)g.Bt + (size_t)nxt.pn * tstep : cB;
        for (int t = 0; t < nt; t += 2) {
            const bool last = (t == nt - 2);
            const char* a1 = cA + (size_t)(t + 1) * kstep;
            const char* a2 = last ? nA : cA + (size_t)(t + 2) * kstep; const char* b2 = last ? nB : cB + (size_t)(t + 2) * kstep;
            const char* a3 = a2 + kstep; const char* b3 = b2 + kstep;
            if (last && has_next) S.a_ready(nxt);
            if constexpr (SP2) {
            PG8_LDB(B0, 0, 0); PG8_LDB(B1, 0, 1); PG8_SCHED; PG8_LDA(At, 0, 0); PG8_STAGE(PG8_SA(1, 1), a1 + hstep, voffA);
            PG8_WAIT_V(8); PG8_WAIT_L(0); PG8_BAR; PG8_MMA(0, 0, At, B0); PG8_MMA(0, 1, At, B1); PG8_BAR; PG8_SCHED;
            PG8_LDA(At, 0, 1); PG8_STAGE(PG8_SB(0, 0), b2, voffB); PG8_STAGE(PG8_SB(0, 1), b2 + hstep, voffB); PG8_STAGE(PG8_SA(0, 0), a2, voffA);
            PG8_WAIT_V(8); PG8_WAIT_L(0); PG8_BAR; PG8_MMA(1, 0, At, B0); PG8_MMA(1, 1, At, B1); PG8_BAR; PG8_SCHED;
            PG8_LDB(B0, 1, 0); PG8_LDB(B1, 1, 1); PG8_SCHED; PG8_LDA(At, 1, 0); PG8_STAGE(PG8_SA(0, 1), a2 + hstep, voffA);
            PG8_WAIT_V(8); PG8_WAIT_L(0); PG8_BAR; PG8_MMA(0, 0, At, B0); PG8_MMA(0, 1, At, B1); PG8_BAR; PG8_SCHED;
            PG8_LDA(At, 1, 1); PG8_STAGE(PG8_SB(1, 0), b3, voffB); PG8_STAGE(PG8_SB(1, 1), b3 + hstep, voffB); PG8_STAGE(PG8_SA(1, 0), a3, voffA);
            PG8_WAIT_V(8); PG8_WAIT_L(0); PG8_BAR; PG8_MMA(1, 0, At, B0); PG8_MMA(1, 1, At, B1); PG8_BAR; PG8_SCHED;
            } else {
            PG8_LDB(B0, 0, 0); PG8_SCHED; PG8_LDA(At, 0, 0); PG8_STAGE(PG8_SA(1, 1), a1 + hstep, voffA);
            PG8_WAIT_L(8); PG8_BAR; PG8_WAIT_L(0); PG8_MMA(0, 0, At, B0); PG8_BAR; PG8_SCHED;
            PG8_LDB(B1, 0, 1); PG8_STAGE(PG8_SB(0, 0), b2, voffB);
            PG8_BAR; PG8_WAIT_L(0); PG8_MMA(0, 1, At, B1); PG8_BAR;
            PG8_LDA(At, 0, 1); PG8_STAGE(PG8_SA(0, 0), a2, voffA);
            PG8_BAR; PG8_WAIT_L(0); PG8_MMA(1, 0, At, B0); PG8_BAR; PG8_SCHED;
            PG8_STAGE(PG8_SB(0, 1), b2 + hstep, voffB);
            PG8_WAIT_V(6); PG8_BAR; PG8_MMA(1, 1, At, B1); PG8_BAR;
            PG8_LDB(B0, 1, 0); PG8_SCHED; PG8_LDA(At, 1, 0); PG8_STAGE(PG8_SA(0, 1), a2 + hstep, voffA);
            PG8_WAIT_L(8); PG8_BAR; PG8_WAIT_L(0); PG8_MMA(0, 0, At, B0); PG8_BAR; PG8_SCHED;
            PG8_LDB(B1, 1, 1); PG8_STAGE(PG8_SB(1, 0), b3, voffB);
            PG8_BAR; PG8_WAIT_L(0); PG8_MMA(0, 1, At, B1); PG8_BAR;
            PG8_LDA(At, 1, 1); PG8_STAGE(PG8_SA(1, 0), a3, voffA);
            PG8_BAR; PG8_WAIT_L(0); PG8_MMA(1, 0, At, B0); PG8_BAR; PG8_SCHED;
            PG8_STAGE(PG8_SB(1, 1), b3 + hstep, voffB);
            PG8_WAIT_V(6); PG8_BAR; PG8_MMA(1, 1, At, B1); PG8_BAR;
            }
        }
        if constexpr (ALIGN_EPI) { if (wr == 0) PG8_BAR; }
        if constexpr (!Epi::AFTER_DRAIN) { E(acc, cur, wr, wc, fr, fq); S.done(cur); }
        if (!has_next) break;
#pragma unroll
        for (int a = 0; a < 2; ++a)
#pragma unroll
            for (int b = 0; b < 2; ++b)
#pragma unroll
                for (int m = 0; m < 4; ++m)
#pragma unroll
                    for (int n = 0; n < 2; ++n) acc[a][b][m][n] = (f32x4){0.f, 0.f, 0.f, 0.f};
        cur = nxt; cA = nA; cB = nB; ++ui;
        if constexpr (ALIGN_EPI) { if (wr == 1) PG8_BAR; }
    }
    PG8_WAIT_V(0);
    if constexpr (!ALIGN_EPI) { if (wr == 0) PG8_BAR; }
    PG8_BAR;
    if constexpr (Epi::AFTER_DRAIN) { E.fused(acc, cur, wr, wc, fr, fq, lds, wid, lane); S.done(cur); }
#undef PG8_SA
#undef PG8_SB
#undef PG8_STAGE
#undef PG8_LDA
#undef PG8_LDB
#undef PG8_MMA
#undef PG8_WAIT_V
#undef PG8_WAIT_L
#undef PG8_BAR
#undef PG8_SCHED
}
}

#define GAS __attribute__((address_space(1)))
#define LAS __attribute__((address_space(3)))
typedef unsigned short bf16;
typedef float f32x4 __attribute__((ext_vector_type(4)));
typedef short bf16x8 __attribute__((ext_vector_type(8)));
typedef unsigned u32x4 __attribute__((ext_vector_type(4)));
typedef unsigned u32x2 __attribute__((ext_vector_type(2)));

constexpr int DM = 1024, SEQ = 8192, MP = 16384, MS = 128, MV = MP + MS, MT = 16640;
constexpr int NABP = 3584, NABV = 3360, FF = 4096;
constexpr int C_V = 1024, C_O = 1536, C_I = 2048, C_QN = 2056, C_KV = 2568, C_WIN = 3080, C_GN = 3336;
constexpr int NPOOL = 2560;
constexpr float EPSN = 1e-6f;
constexpr float QSCALE = 0.125f * 1.4426950408889634f;

constexpr size_t O_YP = 0, O_YS = O_YP + 16777216, O_PCONV = O_YS + 131072, O_PC = O_PCONV + 12288, O_PN = O_PC + 262144, O_PM = O_PN + 2048,
                 O_PKV = O_PM + 16, O_PWIN = O_PKV + 16777216, O_SCONV = O_PWIN + 524288, O_SC = O_SCONV + 196608, O_SN = O_SC + 4194304,
                 O_SM = O_SN + 32768, O_SKV = O_SM + 256, O_SWIN = O_SKV + 131072, O_SGV = O_SWIN + 8388608, O_END = O_SGV + 262144;

constexpr size_t MiB = 1u << 20;
constexpr size_t WS_CTL = 0, CTL_ZERO_BYTES = 1 * MiB;
constexpr size_t WS_MOD = 1 * MiB;
constexpr size_t WS_PEC = 6 * MiB;
constexpr size_t WS_WABIN = 8 * MiB;
constexpr size_t WS_WABOUT = 24 * MiB;
constexpr size_t WS_WCLIN = 28 * MiB;
constexpr size_t WS_WCLOUT = 36 * MiB;
constexpr size_t WS_WF1 = 40 * MiB;
constexpr size_t WS_WF2 = 72 * MiB;
constexpr size_t WS_WPHI = 104 * MiB;
constexpr size_t WS_X = 112 * MiB;
constexpr size_t WS_H = 180 * MiB;
constexpr size_t WS_Z = 216 * MiB;
constexpr size_t WS_MIX = 332 * MiB;
constexpr size_t WS_ACT = 368 * MiB;
constexpr size_t WS_GATE = 500 * MiB;
constexpr size_t WS_QK = 504 * MiB;
constexpr size_t WS_G = 540 * MiB;
constexpr size_t WS_CST = 608 * MiB;
constexpr size_t WS_NU = 672 * MiB;
constexpr size_t WS_NST = 673 * MiB;
constexpr size_t WS_CHK = 674 * MiB;
constexpr size_t WS_MST = 675 * MiB;
constexpr size_t WS_KC = 676 * MiB;
constexpr size_t WS_KCB = 678 * MiB;
constexpr size_t WS_KCS = 680 * MiB;
constexpr size_t WS_A01P = 716 * MiB;
constexpr size_t WS_A01S = 720 * MiB;
constexpr size_t WS_END = 800 * MiB;

constexpr int LDS_BYTES = 163840 - 2048;
constexpr int MISC_OFF = LDS_BYTES - 256;
constexpr int NWAVES = 8, NTHR = 512;

template <class T> __device__ __forceinline__ T* launder(T* p) { asm volatile("" : "+s"(p)); return p; }
__device__ __forceinline__ float bf2f(unsigned h) { return __uint_as_float(h << 16); }
__device__ __forceinline__ unsigned f2bf(float f) { unsigned u = __float_as_uint(f); return (u + 0x7fffu + ((u >> 16) & 1u)) >> 16; }
__device__ __forceinline__ unsigned pk2(float lo, float hi) { return f2bf(lo) | (f2bf(hi) << 16); }
__device__ __forceinline__ float wave_sum(float v) {
#pragma unroll
    for (int o = 1; o < 64; o <<= 1) v += __shfl_xor(v, o);
    return v;
}
__device__ __forceinline__ float wave_max(float v) {
#pragma unroll
    for (int o = 1; o < 64; o <<= 1) v = fmaxf(v, __shfl_xor(v, o));
    return v;
}
__device__ __forceinline__ float sigmoidf_(float x) { return 1.f / (1.f + __expf(-x)); }
__device__ __forceinline__ float siluf_(float x) { return x / (1.f + __expf(-x)); }
__device__ __forceinline__ float logsigmoidf_(float x) { return fminf(x, 0.f) - log1pf(__expf(-fabsf(x))); }
__device__ __forceinline__ float gelu_tanh(float x) { const float u = 1.5957691216f * (x + 0.044715f * x * x * x); return x / (1.f + __expf(-u)); }
__device__ __forceinline__ int mbidx(int row) { return row < MP ? (row >> 13) : 2 + (((row - MP) >> 2) > 31 ? 31 : ((row - MP) >> 2)); }
__device__ __forceinline__ void unpack8(const u32x4 w, float (&o)[8]) {
    o[0] = bf2f(w.x & 0xffffu); o[1] = bf2f(w.x >> 16); o[2] = bf2f(w.y & 0xffffu); o[3] = bf2f(w.y >> 16);
    o[4] = bf2f(w.z & 0xffffu); o[5] = bf2f(w.z >> 16); o[6] = bf2f(w.w & 0xffffu); o[7] = bf2f(w.w >> 16);
}

#define XB_TMO      128
#define XB_XCNT(j)  (256  + 64 * (j))
#define XB_XSUB(j)  (1280 + 64 * (j))
#define XB_XGEN(j)  (2304 + 64 * (j))
#define XB_TOP      3328
#define XB_TOPGEN   3392
#define XCD_BAR_WORDS 3456
#define XB_SPIN_CAP (1u << 18)
__device__ __forceinline__ unsigned xb_ld(unsigned* p)              { return __hip_atomic_load(p, __ATOMIC_RELAXED, __HIP_MEMORY_SCOPE_AGENT); }
__device__ __forceinline__ unsigned xb_add(unsigned* p, unsigned v) { return __hip_atomic_fetch_add(p, v, __ATOMIC_RELAXED, __HIP_MEMORY_SCOPE_AGENT); }
__device__ __forceinline__ unsigned xb_xcc_id() { return (unsigned)__builtin_amdgcn_s_getreg((3 << 11) | 20) & 0xFu; }
#define XB_SPIN(cond, bar) do { unsigned _sp = 0; while (cond) { __builtin_amdgcn_s_sleep(1); \
    if ((++_sp & 255u) == 0u) { if (xb_ld(&(bar)[XB_TMO])) break; if (_sp > XB_SPIN_CAP) { atomicAdd(&(bar)[XB_TMO], 1u); break; } } } } while (0)
struct XcdBarrier { unsigned* bar; unsigned x; volatile LAS unsigned* st; };
__device__ __forceinline__ XcdBarrier xcd_barrier_post(unsigned* bar, volatile LAS unsigned* st) {
    XcdBarrier b; b.bar = bar; b.x = xb_xcc_id(); b.st = st;
    if (threadIdx.x == 0) (void)xb_add(&bar[XB_XCNT(b.x)], 1u);
    return b;
}
__device__ __forceinline__ void xcd_barrier_complete(unsigned* bar, unsigned x, unsigned& nloc, unsigned& nx) {
    const unsigned G = gridDim.x * gridDim.y * gridDim.z;
    unsigned sum, cnt, mine, sp = 0u;
    for (;;) {
        sum = 0u; cnt = 0u; mine = 0u;
#pragma unroll
        for (unsigned j = 0; j < 16; ++j) { const unsigned c = xb_ld(&bar[XB_XCNT(j)]); sum += c; cnt += (c > 0u) ? 1u : 0u; mine = (j == x) ? c : mine; }
        if (sum == G) break;
        __builtin_amdgcn_s_sleep(1);
        if ((++sp & 255u) == 0u) { if (xb_ld(&bar[XB_TMO])) break; if (sp > XB_SPIN_CAP) { atomicAdd(&bar[XB_TMO], 1u); break; } }
    }
    nloc = mine > 0u ? mine : 1u; nx = cnt > 0u ? cnt : 1u;
}
__device__ __forceinline__ void xcd_barrier(const XcdBarrier& b) {
    asm volatile("s_waitcnt vmcnt(0)" ::: "memory");
    __syncthreads();
    if (threadIdx.x == 0) {
        unsigned* bar = b.bar;
        __builtin_amdgcn_s_waitcnt(0);
        unsigned nloc = b.st[0], nx = b.st[1];
        if (nloc == 0u) { xcd_barrier_complete(bar, b.x, nloc, nx); b.st[0] = nloc; b.st[1] = nx; }
        const unsigned old = xb_add(&bar[XB_XSUB(b.x)], 1u);
        const unsigned gen = old / nloc;
        if (old + 1u == (gen + 1u) * nloc) {
            __builtin_amdgcn_fence(__ATOMIC_RELEASE, "agent");
            asm volatile("s_waitcnt vmcnt(0)" ::: "memory");
            const unsigned og = xb_add(&bar[XB_TOP], 1u);
            const unsigned tg = og / nx;
            if (og + 1u == (tg + 1u) * nx) xb_add(&bar[XB_TOPGEN], 1u);
            else XB_SPIN(xb_ld(&bar[XB_TOPGEN]) == tg, bar);
            __builtin_amdgcn_fence(__ATOMIC_ACQUIRE, "agent");
            xb_add(&bar[XB_XGEN(b.x)], 1u);
            asm volatile("s_waitcnt vmcnt(0)" ::: "memory");
        } else {
            XB_SPIN(xb_ld(&bar[XB_XGEN(b.x)]) == gen, bar);
            __builtin_amdgcn_fence(__ATOMIC_ACQUIRE, "agent");
            asm volatile("s_waitcnt vmcnt(0)" ::: "memory");
        }
    }
    __syncthreads();
}

struct Params {
    const float *x_prompt, *x_sample, *c_prompt, *c_sample, *st_conv, *st_C, *st_n, *st_m, *cache, *st_win;
    const int* page_table;
    const float *ada_w, *ada_b, *norm_g, *ab_w_in, *ab_b_in, *ml_conv_w, *ml_conv_b, *ml_f_bias, *ml_out_g, *phi_pe, *phi_w1, *phi_b1, *phi_w2, *phi_b2,
                *ab_w_out, *cl_w_in, *cl_b_in, *cl_v_g, *cl_ws, *cl_bs, *cl_w_out, *ffn_w1, *ffn_w2, *final_g;
    float* out; unsigned char* ws;
    int ph_lo, ph_hi, li, pad;
};

namespace pg8 {
__device__ __forceinline__ u32x4 pack8(const f32x4 a, const f32x4 b) { u32x4 w; w.x = cvt_pk_bf16(a[0], a[1]); w.y = cvt_pk_bf16(a[2], a[3]); w.z = cvt_pk_bf16(b[0], b[1]); w.w = cvt_pk_bf16(b[2], b[3]); return w; }
struct EpiAbIn {
    static constexpr bool PERM = true, AFTER_DRAIN = false;
    bf16_t* Z; const float* bias; float* gate; float* out; int j;
    __device__ __forceinline__ void operator()(const f32x4 (&acc)[2][2][4][2], const Unit& u, int wr, int wc, int fr, int fq) const {
#pragma unroll
        for (int bj = 0; bj < 2; ++bj) {
            const int col = u.pn * BM + bj * HALF + wc * 32 + 8 * fq;
            if (col >= NABV) continue;
            const f32x4 b0 = *(const f32x4*)(bias + col), b1 = *(const f32x4*)(bias + col + 4);
#pragma unroll
            for (int ai = 0; ai < 2; ++ai)
#pragma unroll
                for (int m = 0; m < 4; ++m) {
                    const int row = u.pm * BM + ai * HALF + wr * 64 + m * 16 + fr;
                    if (row >= MV) continue;
                    const f32x4 v0 = acc[ai][bj][m][0] + b0, v1 = acc[ai][bj][m][1] + b1;
                    const float qs = (col >= C_QN && col < C_KV) ? QSCALE : 1.f;
                    *(u32x4*)(Z + (size_t)row * NABP + col) = pack8(v0 * qs, v1 * qs);
                    float* dst = nullptr;
                    const bool isp = row < MP; const int b = isp ? (row >> 13) : ((row - MP) >> 2), t = isp ? (row & 8191) : ((row - MP) & 3);
                    if (col >= C_I && col < C_I + 8) dst = gate + (size_t)row * 8;
                    else if (col < 1024) { if (isp) { if (t >= SEQ - 3) dst = out + O_PCONV + ((size_t)(j * 2 + b) * 3 + (t - (SEQ - 3))) * 1024 + col; }
                                           else if (t >= 1) dst = out + O_SCONV + ((size_t)(j * 32 + b) * 3 + (t - 1)) * 1024 + col; }
                    else if (col >= C_KV && col < C_WIN) { dst = isp ? out + O_PKV + ((size_t)(j * 2 + b) * SEQ + t) * 512 + (col - C_KV) : out + O_SKV + ((size_t)(j * 32 + b) * 4 + t) * 512 + (col - C_KV); }
                    else if (col >= C_WIN && col < C_GN) { if (isp) { if (t >= SEQ - 512) dst = out + O_PWIN + ((size_t)(j * 2 + b) * 512 + (t - (SEQ - 512))) * 256 + (col - C_WIN); }
                                                           else dst = out + O_SWIN + ((size_t)(j * 32 + b) * 512 + 508 + t) * 256 + (col - C_WIN); }
                    if (dst) { *(f32x4*)dst = v0; *(f32x4*)(dst + 4) = v1; }
                }
        }
    }
};
struct EpiResid {
    static constexpr bool PERM = false, AFTER_DRAIN = false;
    float* X; const float* mod;
    __device__ __forceinline__ void operator()(const f32x4 (&acc)[2][2][4][2], const Unit& u, int wr, int wc, int fr, int fq) const {
#pragma unroll
        for (int ai = 0; ai < 2; ++ai)
#pragma unroll
            for (int m = 0; m < 4; ++m) {
                const int row = u.pm * BM + ai * HALF + wr * 64 + m * 16 + fr;
                if (row >= MV) continue;
                const float* g = mod + (size_t)mbidx(row) * 6144; float* xr = X + (size_t)row * DM;
#pragma unroll
                for (int bj = 0; bj < 2; ++bj)
#pragma unroll
                    for (int n = 0; n < 2; ++n) { const int col = u.pn * BM + bj * HALF + wc * 32 + 16 * n + 4 * fq;
                        const f32x4 gv = *(const f32x4*)(g + col); f32x4 xv = *(const f32x4*)(xr + col); xv = xv + gv * acc[ai][bj][m][n]; *(f32x4*)(xr + col) = xv; }
            }
    }
};
template <int ACT> struct EpiAct {
    static constexpr bool PERM = true, AFTER_DRAIN = false;
    bf16_t* O; int ldc; const float* bias;
    __device__ __forceinline__ void operator()(const f32x4 (&acc)[2][2][4][2], const Unit& u, int wr, int wc, int fr, int fq) const {
#pragma unroll
        for (int bj = 0; bj < 2; ++bj) {
            const int col = u.pn * BM + bj * HALF + wc * 32 + 8 * fq;
            f32x4 b0 = (f32x4){0.f, 0.f, 0.f, 0.f}, b1 = b0;
            if (ACT == 1) { b0 = *(const f32x4*)(bias + col); b1 = *(const f32x4*)(bias + col + 4); }
#pragma unroll
            for (int ai = 0; ai < 2; ++ai)
#pragma unroll
                for (int m = 0; m < 4; ++m) {
                    const int row = u.pm * BM + ai * HALF + wr * 64 + m * 16 + fr;
                    f32x4 v0 = acc[ai][bj][m][0] + b0, v1 = acc[ai][bj][m][1] + b1;
#pragma unroll
                    for (int e = 0; e < 4; ++e) {
                        if (ACT == 0) { const float a = fmaxf(v0[e], 0.f), c = fmaxf(v1[e], 0.f); v0[e] = a * a; v1[e] = c * c; }
                        else { v0[e] = gelu_tanh(v0[e]); v1[e] = gelu_tanh(v1[e]); }
                    }
                    *(u32x4*)(O + (size_t)row * ldc + col) = pack8(v0, v1);
                }
        }
    }
};
}

template <class LA, class LB, class EP>
__device__ __forceinline__ void tile_gemm_64x128(unsigned char* lds, int tid, int K, const LA& la, const LB& lb, const EP& epi) {
    const int lane = tid & 63, wid = tid >> 6, wm = wid >> 2, wn = wid & 3, fr = lane & 15, fq = lane >> 4;
    bf16* As = (bf16*)lds; bf16* Bs = (bf16*)(lds + 64 * 144);
    const int lr = tid >> 3, lk = (tid & 7) * 8;
    f32x4 acc[2][2];
#pragma unroll
    for (int a = 0; a < 2; ++a)
#pragma unroll
        for (int b = 0; b < 2; ++b) acc[a][b] = (f32x4){0.f, 0.f, 0.f, 0.f};
    bf16x8 ra = la(lr, lk), rb0 = lb(lr, lk), rb1 = lb(lr + 64, lk);
    for (int k0 = 0; k0 < K; k0 += 64) {
        __syncthreads();
        *(bf16x8*)(As + lr * 72 + lk) = ra; *(bf16x8*)(Bs + lr * 72 + lk) = rb0; *(bf16x8*)(Bs + (lr + 64) * 72 + lk) = rb1;
        __syncthreads();
        if (k0 + 64 < K) { ra = la(lr, k0 + 64 + lk); rb0 = lb(lr, k0 + 64 + lk); rb1 = lb(lr + 64, k0 + 64 + lk); }
#pragma unroll
        for (int ks = 0; ks < 2; ++ks) {
            bf16x8 af[2], bfv[2];
#pragma unroll
            for (int i = 0; i < 2; ++i) { af[i] = *(const bf16x8*)(As + (wm * 32 + i * 16 + fr) * 72 + ks * 32 + fq * 8); bfv[i] = *(const bf16x8*)(Bs + (wn * 32 + i * 16 + fr) * 72 + ks * 32 + fq * 8); }
#pragma unroll
            for (int mi = 0; mi < 2; ++mi)
#pragma unroll
                for (int ni = 0; ni < 2; ++ni) acc[mi][ni] = __builtin_amdgcn_mfma_f32_16x16x32_bf16(bfv[ni], af[mi], acc[mi][ni], 0, 0, 0);
        }
    }
#pragma unroll
    for (int mi = 0; mi < 2; ++mi)
#pragma unroll
        for (int ni = 0; ni < 2; ++ni) epi(wm * 32 + mi * 16 + fr, wn * 32 + ni * 16 + 4 * fq, acc[mi][ni]);
    __syncthreads();
}

struct Ctx { LAS unsigned char* ldsl; unsigned char* lds; int tid, lane, wave, bid, G; };
__device__ __forceinline__ Ctx relaunder(const Ctx& C0) {
    Ctx C = C0; asm volatile("" : "+v"(C.tid)); asm volatile("" : "+s"(C.ldsl)); C.lds = (unsigned char*)C.ldsl; asm volatile("" : "+s"(C.bid)); C.lane = C.tid & 63; C.wave = __builtin_amdgcn_readfirstlane(C.tid >> 6); return C; }

__device__ __forceinline__ void transpose_item(const float* W, int K, int N, bf16* WT, int item, float* scr, int lane) {
    const int nblk = N / 32, kb = item / nblk, nb = item % nblk, k0 = 64 * kb, n0 = 32 * nb;
#pragma unroll 8
    for (int i = 0; i < 32; ++i) { const int kk = 2 * i + (lane >> 5); scr[kk * 33 + (lane & 31)] = W[(size_t)(k0 + kk) * N + n0 + (lane & 31)]; }
    asm volatile("s_waitcnt lgkmcnt(0)" ::: "memory");
    const int c = lane & 7;
#pragma unroll
    for (int j = 0; j < 4; ++j) { const int n = (lane >> 3) + 8 * j; const float* s = scr + (8 * c) * 33 + n;
        u32x4 o; o.x = pk2(s[0 * 33], s[1 * 33]); o.y = pk2(s[2 * 33], s[3 * 33]); o.z = pk2(s[4 * 33], s[5 * 33]); o.w = pk2(s[6 * 33], s[7 * 33]);
        *(u32x4*)(WT + (size_t)(n0 + n) * K + k0 + 8 * c) = o; }
    asm volatile("s_waitcnt lgkmcnt(0)" ::: "memory");
}

__device__ __forceinline__ void job_transposes(const Params& P, const Ctx& C0) { unsigned char* const wsb = launder(P.ws); const Ctx C = relaunder(C0);
    float* scr = (float*)(C.lds + C.wave * 8448);
    const int gw = C.bid * NWAVES + C.wave, NGW = C.G * NWAVES;
    constexpr int I_ABIN = 16 * 105, I_SQ = 16 * 32, I_CLIN = 16 * 64, I_F1 = 16 * 128, I_F2 = 64 * 32, I_PHI = 16 * 2;
    constexpr int NIT = 2 * I_ABIN + 2 * I_SQ + 2 * I_CLIN + 2 * I_SQ + 4 * I_F1 + 4 * I_F2 + 8 * I_PHI;
    unsigned char* ws = wsb;
    for (int it = gw; it < NIT; it += NGW) {
        int r = it;
        if (r < 2 * I_ABIN) { const int j = r / I_ABIN; transpose_item(P.ab_w_in + (size_t)j * DM * NABV, DM, NABV, (bf16*)(ws + WS_WABIN) + (size_t)j * NABP * DM, r % I_ABIN, scr, C.lane); continue; } r -= 2 * I_ABIN;
        if (r < 2 * I_SQ) { const int j = r / I_SQ; transpose_item(P.ab_w_out + (size_t)j * DM * DM, DM, DM, (bf16*)(ws + WS_WABOUT) + (size_t)j * DM * DM, r % I_SQ, scr, C.lane); continue; } r -= 2 * I_SQ;
        if (r < 2 * I_CLIN) { const int j = r / I_CLIN; transpose_item(P.cl_w_in + (size_t)j * DM * 2048, DM, 2048, (bf16*)(ws + WS_WCLIN) + (size_t)j * 2048 * DM, r % I_CLIN, scr, C.lane); continue; } r -= 2 * I_CLIN;
        if (r < 2 * I_SQ) { const int j = r / I_SQ; transpose_item(P.cl_w_out + (size_t)j * DM * DM, DM, DM, (bf16*)(ws + WS_WCLOUT) + (size_t)j * DM * DM, r % I_SQ, scr, C.lane); continue; } r -= 2 * I_SQ;
        if (r < 4 * I_F1) { const int l = r / I_F1; transpose_item(P.ffn_w1 + (size_t)l * DM * FF, DM, FF, (bf16*)(ws + WS_WF1) + (size_t)l * FF * DM, r % I_F1, scr, C.lane); continue; } r -= 4 * I_F1;
        if (r < 4 * I_F2) { const int l = r / I_F2; transpose_item(P.ffn_w2 + (size_t)l * FF * DM, FF, DM, (bf16*)(ws + WS_WF2) + (size_t)l * DM * FF, r % I_F2, scr, C.lane); continue; } r -= 4 * I_F2;
        { const int q = r / I_PHI;
          transpose_item(P.phi_w1 + ((size_t)(q >> 1) * 2048 + (size_t)(q & 1) * 1024) * 64, 1024, 64, (bf16*)(ws + WS_WPHI) + ((size_t)(q >> 1) * 128 + (size_t)(q & 1) * 64) * 1024, r % I_PHI, scr, C.lane); }
    }
    const int gt = C.bid * NTHR + C.tid, NGT = C.G * NTHR;
    for (int i = gt; i < 2 * (NABP - NABV) * DM / 8; i += NGT) { const int j = i / ((NABP - NABV) * DM / 8), o = i % ((NABP - NABV) * DM / 8);
        *(u32x4*)((bf16*)(ws + WS_WABIN) + ((size_t)j * NABP + NABV) * DM + (size_t)o * 8) = (u32x4){0u, 0u, 0u, 0u}; }
}

__device__ __forceinline__ void job_copy_x(const Params& P, const Ctx& C0) { unsigned char* const wsb = launder(P.ws); const Ctx C = relaunder(C0);
    float* X = (float*)(wsb + WS_X);
    const int gw = C.bid * NWAVES + C.wave, NGW = C.G * NWAVES;
    for (int r = gw; r < MT; r += NGW) {
        f32x4* dst = (f32x4*)(X + (size_t)r * DM) + C.lane;
        if (r < MV) { const f32x4* src = (const f32x4*)(r < MP ? P.x_prompt + (size_t)r * DM : P.x_sample + (size_t)(r - MP) * DM) + C.lane;
#pragma unroll
            for (int i = 0; i < 4; ++i) dst[64 * i] = src[64 * i]; }
        else {
#pragma unroll
            for (int i = 0; i < 4; ++i) dst[64 * i] = (f32x4){0.f, 0.f, 0.f, 0.f}; }
    }
    const int gt = C.bid * NTHR + C.tid, NGT = C.G * NTHR;
    for (int i = gt; i < 64 * 508 * 64; i += NGT) { const int jb = i / (508 * 64), o = i % (508 * 64);
        ((f32x4*)(P.out + O_SWIN + (size_t)jb * 512 * 256))[o] = ((const f32x4*)(P.st_win + (size_t)jb * 512 * 256 + 4 * 256))[o]; }
    if (gw < 4) { const float* pe = P.phi_pe + (size_t)gw * 2048; const float* w1 = P.phi_w1 + (size_t)gw * 2048 * 64; float a = P.phi_b1[gw * 64 + C.lane];
        for (int kk = 0; kk < 2048; ++kk) a += pe[kk] * w1[(size_t)kk * 64 + C.lane];
        ((float*)(wsb + WS_PEC))[gw * 64 + C.lane] = a; }
}

__device__ __forceinline__ void job_adaln(const Params& P, const Ctx& C0) { unsigned char* const wsb = launder(P.ws); const Ctx C = relaunder(C0);
    float* SC = (float*)C.lds;
    __syncthreads();
    for (int i = C.tid; i < 34 * 1024; i += NTHR) { const int mb = i >> 10, k = i & 1023; const float c = mb < 2 ? P.c_prompt[mb * 1024 + k] : P.c_sample[(mb - 2) * 1024 + k]; SC[k * 36 + mb] = siluf_(c); }
    __syncthreads();
    float* MOD = (float*)(wsb + WS_MOD);
    const int gw = C.bid * NWAVES + C.wave, NGW = C.G * NWAVES, ks = C.lane >> 4, cl = C.lane & 15;
    for (int u = gw; u < 4 * 384; u += NGW) {
        const int l = u / 384, n = (u % 384) * 16 + cl;
        const float* w = P.ada_w + (size_t)l * DM * 6144 + n;
        float acc[34];
#pragma unroll
        for (int i = 0; i < 34; ++i) acc[i] = 0.f;
        for (int k = ks; k < 1024; k += 4) {
            const float wv = w[(size_t)k * 6144];
            const f32x4* s4 = (const f32x4*)(SC + k * 36);
#pragma unroll
            for (int q = 0; q < 8; ++q) { const f32x4 s = s4[q]; acc[4 * q] += s[0] * wv; acc[4 * q + 1] += s[1] * wv; acc[4 * q + 2] += s[2] * wv; acc[4 * q + 3] += s[3] * wv; }
            { const f32x4 s = s4[8]; acc[32] += s[0] * wv; acc[33] += s[1] * wv; }
        }
#pragma unroll
        for (int i = 0; i < 34; ++i) { float a = acc[i]; a += __shfl_xor(a, 16); a += __shfl_xor(a, 32); acc[i] = a; }
        if (ks == 0) { const float bb = P.ada_b[l * 6144 + n];
#pragma unroll
            for (int i = 0; i < 34; ++i) MOD[((size_t)l * 34 + i) * 6144 + n] = acc[i] + bb; }
    }
    __syncthreads();
}

template <bool FINAL>
__device__ __forceinline__ void job_norm(const Params& P, const Ctx& C0, int l, int idx) { unsigned char* const wsb = launder(P.ws); const Ctx C = relaunder(C0);
    const float* X = (const float*)(wsb + WS_X); bf16* H = (bf16*)(wsb + WS_H); const float* MOD = (const float*)(wsb + WS_MOD);
    const int gw = C.bid * NWAVES + C.wave, NGW = C.G * NWAVES;
    const float* g = FINAL ? P.final_g : P.norm_g + (size_t)(l * 2 + idx) * DM;
    for (int r = gw; r < (FINAL ? MV : MT); r += NGW) {
        if (!FINAL && r >= MV) { u32x2* o = (u32x2*)(H + (size_t)r * DM) + C.lane;
#pragma unroll
            for (int i = 0; i < 4; ++i) o[64 * i] = (u32x2){0u, 0u};
            continue; }
        const f32x4* xr = (const f32x4*)(X + (size_t)r * DM) + C.lane;
        f32x4 v[4]; float s = 0.f;
#pragma unroll
        for (int i = 0; i < 4; ++i) { v[i] = xr[64 * i]; s += (v[i][0] * v[i][0] + v[i][1] * v[i][1]) + (v[i][2] * v[i][2] + v[i][3] * v[i][3]); }
        const float rstd = rsqrtf(wave_sum(s) * (1.f / DM) + EPSN);
        if (FINAL) { f32x4* o = (f32x4*)(P.out + (r < MP ? O_YP + (size_t)r * DM : O_YS + (size_t)(r - MP) * DM)) + C.lane;
#pragma unroll
            for (int i = 0; i < 4; ++i) { const f32x4 gv = ((const f32x4*)g)[C.lane + 64 * i]; o[64 * i] = v[i] * rstd * gv; } }
        else { const float* mr = MOD + ((size_t)l * 34 + mbidx(r)) * 6144; const f32x4* sh = (const f32x4*)(mr + (idx ? 3 : 0) * DM) + C.lane; const f32x4* sc = (const f32x4*)(mr + (idx ? 4 : 1) * DM) + C.lane;
            u32x2* o = (u32x2*)(H + (size_t)r * DM) + C.lane;
#pragma unroll
            for (int i = 0; i < 4; ++i) { const f32x4 gv = ((const f32x4*)g)[C.lane + 64 * i]; const f32x4 y = v[i] * rstd * gv * (sc[64 * i] + 1.f) + sh[64 * i]; o[64 * i] = (u32x2){pk2(y[0], y[1]), pk2(y[2], y[3])}; } }
    }
}

template <bool SAMPLE>
__device__ __forceinline__ void job_compress1(const Params& P, const Ctx& C0, int j) { unsigned char* const wsb = launder(P.ws); const Ctx C = relaunder(C0);
    const int NB = SAMPLE ? 32 : 2, ntile = 2 * NB * 512 * 2 / 64;
    const bf16* Z = (const bf16*)(wsb + WS_Z);
    float* A01 = SAMPLE ? (float*)(wsb + WS_A01S) + (size_t)j * 65536 * 128 : (float*)(wsb + WS_A01P);
    for (int tl = C.bid; tl < ntile; tl += C.G) {
        const int row0 = tl * 64, type = row0 / (NB * 1024);
        const bf16* W = (const bf16*)(wsb + WS_WPHI) + (size_t)(j * 2 + type) * 128 * 1024;
        auto la = [&](int r, int k) -> bf16x8 {
            const int row = row0 + r, g = row & 1, i = (row >> 1) & 511, b = (row >> 10) % NB, p = k >> 6, d = k & 63, pos = i * 16 + p;
            if (SAMPLE) { const int page = P.page_table[b * 64 + (pos >> 7)];
                const float* src = P.cache + ((((size_t)j * NPOOL + page) * 128 + (pos & 127)) * 4 + type) * 128 + g * 64 + d;
                const f32x4 a = *(const f32x4*)src, c = *(const f32x4*)(src + 4);
                u32x4 w; w.x = pk2(a[0], a[1]); w.y = pk2(a[2], a[3]); w.z = pk2(c[0], c[1]); w.w = pk2(c[2], c[3]); return __builtin_bit_cast(bf16x8, w); }
            else return *(const bf16x8*)(Z + (size_t)(b * SEQ + pos) * NABP + C_KV + type * 128 + g * 64 + d);
        };
        auto lb = [&](int n, int k) -> bf16x8 { return *(const bf16x8*)(W + (size_t)n * 1024 + k); };
        auto ep = [&](int r, int c, f32x4 v) { *(f32x4*)(A01 + (size_t)(row0 + r) * 128 + c) = v; };
        tile_gemm_64x128(C.lds, C.tid, 1024, la, lb, ep);
    }
}
template <bool SAMPLE>
__device__ __forceinline__ void job_compress2(const Params& P, const Ctx& C0, int j) { unsigned char* const wsb = launder(P.ws); const Ctx C = relaunder(C0);
    const int NB = SAMPLE ? 32 : 2, nrow = 2 * NB * 511 * 2;
    const float* A01 = SAMPLE ? (const float*)(wsb + WS_A01S) + (size_t)j * 65536 * 128 : (const float*)(wsb + WS_A01P);
    float* KC = SAMPLE ? (float*)(wsb + WS_KCS) + (size_t)j * 2 * 32 * 512 * 128 : (float*)(wsb + WS_KC);
    const float* PEC = (const float*)(wsb + WS_PEC);
    const int gw = C.bid * NWAVES + C.wave, NGW = C.G * NWAVES;
    for (int u = gw; u < nrow; u += NGW) {
        const int g = u & 1, n = (u >> 1) % 511, tb = (u >> 1) / 511, type = tb / NB, b = tb % NB;
        const size_t r0 = ((size_t)(type * NB + b) * 512 + n) * 2 + g;
        const float pre = PEC[(j * 2 + type) * 64 + C.lane] + A01[r0 * 128 + C.lane] + A01[(r0 + 2) * 128 + 64 + C.lane];
        const float hid = gelu_tanh(pre);
        const float* w2 = P.phi_w2 + (size_t)(j * 2 + type) * 4096;
        float a = P.phi_b2[(j * 2 + type) * 64 + C.lane];
#pragma unroll 8
        for (int hc = 0; hc < 64; ++hc) a += __shfl(hid, hc) * w2[hc * 64 + C.lane];
        KC[r0 * 64 + C.lane] = a;
        if (!SAMPLE) ((bf16*)(wsb + WS_KCB))[r0 * 64 + C.lane] = (bf16)f2bf(a);
    }
}

__device__ __forceinline__ void job_mlstm_local(const Params& P, const Ctx& C0, int j) { unsigned char* const wsb = launder(P.ws); const Ctx C = relaunder(C0);
    const bf16* Z = (const bf16*)(wsb + WS_Z); const float* GT = (const float*)(wsb + WS_GATE); bf16* QK = (bf16*)(wsb + WS_QK);
    float* G = (float*)(wsb + WS_G); float* NU = (float*)(wsb + WS_NU); float* CHK = (float*)(wsb + WS_CHK);
    float* kf = (float*)C.lds; float* vf = kf + 64 * 128; float* wts = vf + 64 * 128;
    const int tid = C.tid;
    for (int u = C.bid; u < 1024; u += C.G) {
        const int bh = u >> 7, c = u & 127, b = bh >> 2, h = bh & 3, r0 = b * SEQ + c * 64;
        __syncthreads();
        if (C.wave == 0) {
            const int t = C.lane; const float li = GT[(size_t)(r0 + t) * 8 + h]; const float lf = logsigmoidf_(GT[(size_t)(r0 + t) * 8 + 4 + h] + P.ml_f_bias[j * 4 + h]);
            float bt = lf;
#pragma unroll
            for (int o = 1; o < 64; o <<= 1) { const float y = __shfl_up(bt, o); if (t >= o) bt += y; }
            const float bl = __shfl(bt, 63), gs = bl - bt + li, gm = wave_max(gs);
            wts[t] = __expf(gs - gm);
            if (t == 0) { CHK[u * 4] = bl; CHK[u * 4 + 1] = gm; }
        }
        {
            const int cc = tid & 255, t0 = (tid >> 8) * 32, col = cc < 128 ? h * 128 + cc : 512 + h * 128 + (cc - 128);
            const float* cw = P.ml_conv_w + (size_t)j * 4 * 1024 + col; const float w0 = cw[0], w1 = cw[1024], w2 = cw[2048], w3 = cw[3072], cb = P.ml_conv_b[j * 1024 + col];
            float x0, x1, x2;
            { const int tg = c * 64 + t0; const bf16* zp = Z + (size_t)(r0 + t0) * NABP + col;
              x0 = tg >= 3 ? bf2f(*(zp - 3 * NABP)) : 0.f; x1 = tg >= 2 ? bf2f(*(zp - 2 * NABP)) : 0.f; x2 = tg >= 1 ? bf2f(*(zp - NABP)) : 0.f; }
#pragma unroll 4
            for (int i = 0; i < 32; ++i) { const int t = t0 + i; const float x3 = bf2f(Z[(size_t)(r0 + t) * NABP + col]);
                const float y = cb + w0 * x0 + w1 * x1 + w2 * x2 + w3 * x3; float s = siluf_(y); if (cc >= 128) s *= 0.08838834764831845f;
                const unsigned hb = f2bf(s); QK[(size_t)(r0 + t) * 1024 + col] = (bf16)hb; if (cc >= 128) kf[t * 128 + (cc - 128)] = bf2f(hb);
                x0 = x1; x1 = x2; x2 = x3; }
            for (int i = tid; i < 64 * 128; i += NTHR) { const int t = i >> 7, e = i & 127; vf[i] = bf2f(Z[(size_t)(r0 + t) * NABP + C_V + h * 128 + e]); }
        }
        __syncthreads();
        const int d0 = (tid >> 4) * 4, e0 = (tid & 15) * 8;
        float acc[4][8], nu[4];
#pragma unroll
        for (int a = 0; a < 4; ++a) { nu[a] = 0.f;
#pragma unroll
            for (int e = 0; e < 8; ++e) acc[a][e] = 0.f; }
        for (int s = 0; s < 64; ++s) {
            const float w = wts[s]; const f32x4 k4 = *(const f32x4*)(kf + s * 128 + d0) * w; const f32x4 va = *(const f32x4*)(vf + s * 128 + e0), vb = *(const f32x4*)(vf + s * 128 + e0 + 4);
#pragma unroll
            for (int a = 0; a < 4; ++a) { nu[a] += k4[a];
#pragma unroll
                for (int e = 0; e < 4; ++e) { acc[a][e] += k4[a] * va[e]; acc[a][4 + e] += k4[a] * vb[e]; } }
        }
#pragma unroll
        for (int a = 0; a < 4; ++a) { float* gp = G + ((size_t)u * 128 + d0 + a) * 128 + e0; *(f32x4*)gp = (f32x4){acc[a][0], acc[a][1], acc[a][2], acc[a][3]}; *(f32x4*)(gp + 4) = (f32x4){acc[a][4], acc[a][5], acc[a][6], acc[a][7]};
            if ((tid & 15) == 0) NU[u * 128 + d0 + a] = nu[a]; }
    }
    __syncthreads();
}

__device__ __forceinline__ void job_mlstm_scan(const Params& P, const Ctx& C0, int j) { unsigned char* const wsb = launder(P.ws); const Ctx C = relaunder(C0);
    const float* G = (const float*)(wsb + WS_G); const float* NU = (const float*)(wsb + WS_NU); const float* CHK = (const float*)(wsb + WS_CHK);
    float* CST = (float*)(wsb + WS_CST); float* NST = (float*)(wsb + WS_NST); float* MST = (float*)(wsb + WS_MST);
    float* dec = (float*)C.lds; float* scl = dec + 128; float* blv = scl + 128; float* gmv = blv + 128; float* mfin = gmv + 128;
    for (int u = C.bid; u < 8 * 33; u += C.G) {
        const int bh = u / 33, sl = u % 33, b = bh >> 2, h = bh & 3;
        __syncthreads();
        if (C.tid < 128) { blv[C.tid] = CHK[(bh * 128 + C.tid) * 4]; gmv[C.tid] = CHK[(bh * 128 + C.tid) * 4 + 1]; }
        __syncthreads();
        if (C.tid == 0) { float m = 0.f;
            for (int c = 0; c < 128; ++c) { const float mn = fmaxf(m + blv[c], gmv[c]); dec[c] = __expf(m + blv[c] - mn); scl[c] = __expf(gmv[c] - mn); if (sl == 0) MST[bh * 128 + c] = m; m = mn; }
            mfin[0] = m; if (sl == 0) P.out[O_PM + (j * 2 + b) * 4 + h] = m; }
        __syncthreads();
        if (sl < 32) { const int el = sl * 512 + C.tid; float cv = 0.f;
#pragma unroll 8
            for (int c = 0; c < 128; ++c) { const size_t o = ((size_t)(bh * 128 + c)) * 16384 + el; CST[o] = cv; cv = dec[c] * cv + scl[c] * G[o]; }
            P.out[O_PC + ((size_t)(j * 2 + b) * 4 + h) * 16384 + el] = cv; }
        else if (C.tid < 128) { float nv = 0.f;
            for (int c = 0; c < 128; ++c) { const size_t o = (size_t)(bh * 128 + c) * 128 + C.tid; NST[o] = nv; nv = dec[c] * nv + scl[c] * NU[o]; }
            P.out[O_PN + ((size_t)(j * 2 + b) * 4 + h) * 128 + C.tid] = nv; }
    }
    __syncthreads();
}

__device__ __forceinline__ void job_mlstm_out(const Params& P, const Ctx& C0, int j) { unsigned char* const wsb = launder(P.ws); const Ctx C = relaunder(C0);
    const bf16* Z = (const bf16*)(wsb + WS_Z); const float* GT = (const float*)(wsb + WS_GATE); const bf16* QK = (const bf16*)(wsb + WS_QK);
    const float* CST = (const float*)(wsb + WS_CST); const float* NST = (const float*)(wsb + WS_NST); const float* MST = (const float*)(wsb + WS_MST);
    bf16* MIX = (bf16*)(wsb + WS_MIX);
    bf16* qb = (bf16*)C.lds; bf16* kb = qb + 64 * 128; bf16* vb = kb + 64 * 128; float* Cl = (float*)(C.lds + 49152); float* S = (float*)(C.lds + 49152 + 65536);
    float* misc = (float*)(C.lds + 49152 + 65536 + 16384); float* btv = misc, *mtv = misc + 64, *wiv = misc + 128, *libv = misc + 192, *nvec = misc + 256, *qn = misc + 384;
    const int tid = C.tid;
    for (int u = C.bid; u < 1024; u += C.G) {
        const int bh = u >> 7, c = u & 127, b = bh >> 2, h = bh & 3, r0 = b * SEQ + c * 64;
        __syncthreads();
        if (C.wave == 0) {
            const int t = C.lane; const float li = GT[(size_t)(r0 + t) * 8 + h]; const float lf = logsigmoidf_(GT[(size_t)(r0 + t) * 8 + 4 + h] + P.ml_f_bias[j * 4 + h]);
            float bt = lf;
#pragma unroll
            for (int o = 1; o < 64; o <<= 1) { const float y = __shfl_up(bt, o); if (t >= o) bt += y; }
            float pm = li - bt;
#pragma unroll
            for (int o = 1; o < 64; o <<= 1) { const float y = __shfl_up(pm, o); if (t >= o) pm = fmaxf(pm, y); }
            const float m = MST[u], mt = bt + fmaxf(m, pm);
            btv[t] = bt; mtv[t] = mt; wiv[t] = __expf(m + bt - mt); libv[t] = li - bt;
        }
        for (int i = tid; i < 1024; i += NTHR) { const int t = i >> 4, ch = (i & 15) * 8;
            *(u32x4*)(qb + t * 128 + ch) = *(const u32x4*)(QK + (size_t)(r0 + t) * 1024 + h * 128 + ch);
            *(u32x4*)(kb + t * 128 + ch) = *(const u32x4*)(QK + (size_t)(r0 + t) * 1024 + 512 + h * 128 + ch);
            *(u32x4*)(vb + t * 128 + ch) = *(const u32x4*)(Z + (size_t)(r0 + t) * NABP + C_V + h * 128 + ch); }
        for (int i = tid; i < 4096; i += NTHR) ((f32x4*)Cl)[i] = ((const f32x4*)(CST + (size_t)u * 16384))[i];
        if (tid < 128) nvec[tid] = NST[u * 128 + tid];
        __syncthreads();
        {
            const int t = tid >> 3, s0 = (tid & 7) * 8; float dot[8]; float qnp = 0.f;
#pragma unroll
            for (int i = 0; i < 8; ++i) dot[i] = 0.f;
            for (int d8 = 0; d8 < 16; ++d8) { float q8[8]; unpack8(*(const u32x4*)(qb + t * 128 + d8 * 8), q8);
                if ((d8 >> 1) == (tid & 7)) {
#pragma unroll
                    for (int e = 0; e < 8; ++e) qnp += q8[e] * nvec[d8 * 8 + e]; }
#pragma unroll
                for (int i = 0; i < 8; ++i) { float k8[8]; unpack8(*(const u32x4*)(kb + (s0 + i) * 128 + d8 * 8), k8);
#pragma unroll
                    for (int e = 0; e < 8; ++e) dot[i] += q8[e] * k8[e]; } }
            qnp += __shfl_xor(qnp, 1); qnp += __shfl_xor(qnp, 2); qnp += __shfl_xor(qnp, 4);
            if ((tid & 7) == 0) qn[t] = qnp;
            const float bm = btv[t] - mtv[t];
#pragma unroll
            for (int i = 0; i < 8; ++i) { const int s = s0 + i; S[t * 64 + s] = s <= t ? dot[i] * __expf(bm + libv[s]) : 0.f; }
        }
        __syncthreads();
        {
            const int t = tid >> 3, e0 = (tid & 7) * 16; float acc[16], aci[16]; float rs = 0.f;
#pragma unroll
            for (int e = 0; e < 16; ++e) { acc[e] = 0.f; aci[e] = 0.f; }
            for (int s = 0; s <= t; ++s) { const float a = S[t * 64 + s]; rs += a; float v0[8], v1[8]; unpack8(*(const u32x4*)(vb + s * 128 + e0), v0); unpack8(*(const u32x4*)(vb + s * 128 + e0 + 8), v1);
#pragma unroll
                for (int e = 0; e < 8; ++e) { acc[e] += a * v0[e]; acc[8 + e] += a * v1[e]; } }
#pragma unroll 2
            for (int d = 0; d < 128; ++d) { const float a = bf2f(qb[t * 128 + d]); const f32x4* cp = (const f32x4*)(Cl + d * 128 + e0);
#pragma unroll
                for (int q = 0; q < 4; ++q) { const f32x4 cv = cp[q]; aci[4 * q] += a * cv[0]; aci[4 * q + 1] += a * cv[1]; aci[4 * q + 2] += a * cv[2]; aci[4 * q + 3] += a * cv[3]; } }
            const float wi = wiv[t], den = wi * qn[t] + rs, dn = 1.f / fmaxf(fabsf(den), __expf(-mtv[t]));
            float ss = 0.f;
#pragma unroll
            for (int e = 0; e < 16; ++e) { acc[e] = (wi * aci[e] + acc[e]) * dn; ss += acc[e] * acc[e]; }
            ss += __shfl_xor(ss, 1); ss += __shfl_xor(ss, 2); ss += __shfl_xor(ss, 4);
            const float rstd = rsqrtf(ss * (1.f / 128.f) + EPSN);
            const bf16* op = Z + (size_t)(r0 + t) * NABP + C_O + h * 128 + e0; const float* og = P.ml_out_g + j * 512 + h * 128 + e0;
            float o0[8], o1[8]; unpack8(*(const u32x4*)op, o0); unpack8(*(const u32x4*)(op + 8), o1);
            u32x4 w0, w1;
            float r[16];
#pragma unroll
            for (int e = 0; e < 8; ++e) { r[e] = acc[e] * rstd * og[e] * sigmoidf_(o0[e]); r[8 + e] = acc[8 + e] * rstd * og[8 + e] * sigmoidf_(o1[e]); }
            w0.x = pk2(r[0], r[1]); w0.y = pk2(r[2], r[3]); w0.z = pk2(r[4], r[5]); w0.w = pk2(r[6], r[7]); w1.x = pk2(r[8], r[9]); w1.y = pk2(r[10], r[11]); w1.z = pk2(r[12], r[13]); w1.w = pk2(r[14], r[15]);
            bf16* mp = MIX + (size_t)(r0 + t) * 1024 + h * 128 + e0; *(u32x4*)mp = w0; *(u32x4*)(mp + 8) = w1;
        }
    }
    __syncthreads();
}

__device__ __forceinline__ void job_mlstm_sample(const Params& P, const Ctx& C0, int j) { unsigned char* const wsb = launder(P.ws); const Ctx C = relaunder(C0);
    const bf16* Z = (const bf16*)(wsb + WS_Z); const float* GT = (const float*)(wsb + WS_GATE); bf16* MIX = (bf16*)(wsb + WS_MIX);
    float* qf = (float*)C.lds; float* kf = qf + 512; float* vf = kf + 512; float* hb = vf + 512; float* S = hb + 512; float* sc = S + 16;
    const int tid = C.tid;
    for (int u = C.bid; u < 128; u += C.G) {
        const int sb = u >> 2, h = u & 3, r0 = MP + sb * 4;
        const float* C0 = P.st_C + ((size_t)(j * 32 + sb) * 4 + h) * 16384; const float* n0 = P.st_n + ((size_t)(j * 32 + sb) * 4 + h) * 128;
        __syncthreads();
        if (tid == 0) {
            const float m0 = P.st_m[(j * 32 + sb) * 4 + h]; float bt[4], li[4], pm = -INFINITY, b = 0.f;
#pragma unroll
            for (int t = 0; t < 4; ++t) { li[t] = GT[(size_t)(r0 + t) * 8 + h]; b += logsigmoidf_(GT[(size_t)(r0 + t) * 8 + 4 + h] + P.ml_f_bias[j * 4 + h]); bt[t] = b;
                pm = fmaxf(pm, li[t] - b); const float mt = b + fmaxf(m0, pm); sc[t] = b; sc[4 + t] = mt; sc[8 + t] = __expf(m0 + b - mt); }
            float gm = -INFINITY;
#pragma unroll
            for (int t = 0; t < 4; ++t) gm = fmaxf(gm, bt[3] - bt[t] + li[t]);
            const float mn = fmaxf(m0 + bt[3], gm);
#pragma unroll
            for (int t = 0; t < 4; ++t) { sc[12 + t] = __expf(bt[3] - bt[t] + li[t] - mn); sc[24 + t] = li[t] - bt[t]; }
            sc[20] = __expf(m0 + bt[3] - mn); P.out[O_SM + (j * 32 + sb) * 4 + h] = mn;
        }
        {
            const int cc = tid & 255, col = cc < 128 ? h * 128 + cc : 512 + h * 128 + (cc - 128);
            const float* cw = P.ml_conv_w + (size_t)j * 4 * 1024 + col; const float w0 = cw[0], w1 = cw[1024], w2 = cw[2048], w3 = cw[3072], cb = P.ml_conv_b[j * 1024 + col];
            const float* cbuf = P.st_conv + (size_t)(j * 32 + sb) * 3 * 1024 + col;
            float xs[7];
#pragma unroll
            for (int i = 0; i < 3; ++i) xs[i] = cbuf[i * 1024];
#pragma unroll
            for (int i = 0; i < 4; ++i) xs[3 + i] = bf2f(Z[(size_t)(r0 + i) * NABP + col]);
#pragma unroll
            for (int q = 0; q < 2; ++q) { const int t = (tid >> 8) * 2 + q;
                float y = cb;
                if (t == 0) y += w0 * xs[0] + w1 * xs[1] + w2 * xs[2] + w3 * xs[3]; else if (t == 1) y += w0 * xs[1] + w1 * xs[2] + w2 * xs[3] + w3 * xs[4];
                else if (t == 2) y += w0 * xs[2] + w1 * xs[3] + w2 * xs[4] + w3 * xs[5]; else y += w0 * xs[3] + w1 * xs[4] + w2 * xs[5] + w3 * xs[6];
                float s = siluf_(y); if (cc >= 128) { s *= 0.08838834764831845f; kf[t * 128 + cc - 128] = s; } else qf[t * 128 + cc] = s; }
            { const int t = tid >> 7, e = tid & 127; vf[tid] = bf2f(Z[(size_t)(r0 + t) * NABP + C_V + h * 128 + e]); }
        }
        __syncthreads();
        if (tid < 16) { const int t = tid >> 2, s = tid & 3; float d = 0.f; for (int k = 0; k < 128; ++k) d += qf[t * 128 + k] * kf[s * 128 + k];
            S[tid] = s <= t ? d * __expf(sc[t] - sc[4 + t] + sc[24 + s]) : 0.f; }
        else if (tid >= 64 && tid < 68) { const int t = tid - 64; float d = 0.f; for (int k = 0; k < 128; ++k) d += qf[t * 128 + k] * n0[k]; sc[16 + t] = d; }
        __syncthreads();
        { const int t = tid >> 7, e = tid & 127; float ai = 0.f;
            for (int d = 0; d < 128; ++d) ai += qf[t * 128 + d] * C0[d * 128 + e];
            float a = 0.f, rs = 0.f;
#pragma unroll
            for (int s = 0; s < 4; ++s) { a += S[t * 4 + s] * vf[s * 128 + e]; rs += S[t * 4 + s]; }
            const float wi = sc[8 + t], den = wi * sc[16 + t] + rs;
            hb[tid] = (wi * ai + a) / fmaxf(fabsf(den), __expf(-sc[4 + t])); }
        __syncthreads();
        { const int t = tid >> 7, e = tid & 127; float ss = 0.f; for (int k = 0; k < 128; ++k) ss += hb[t * 128 + k] * hb[t * 128 + k];
            const float rstd = rsqrtf(ss * (1.f / 128.f) + EPSN), o = bf2f(Z[(size_t)(r0 + t) * NABP + C_O + h * 128 + e]);
            MIX[(size_t)(r0 + t) * 1024 + h * 128 + e] = (bf16)f2bf(hb[tid] * rstd * P.ml_out_g[j * 512 + h * 128 + e] * sigmoidf_(o)); }
        { const float decay = sc[20]; float* Co = P.out + O_SC + ((size_t)(j * 32 + sb) * 4 + h) * 16384;
            for (int i = 0; i < 32; ++i) { const int idx = i * 512 + tid, d = idx >> 7, e = idx & 127; float a = decay * C0[idx];
#pragma unroll
                for (int s = 0; s < 4; ++s) a += sc[12 + s] * kf[s * 128 + d] * vf[s * 128 + e];
                Co[idx] = a; }
            if (tid < 128) { float a = decay * n0[tid];
#pragma unroll
                for (int s = 0; s < 4; ++s) a += sc[12 + s] * kf[s * 128 + tid];
                P.out[O_SN + ((size_t)(j * 32 + sb) * 4 + h) * 128 + tid] = a; } }
    }
    __syncthreads();
}

namespace nsa {
typedef float f32x16 __attribute__((ext_vector_type(16)));
typedef short s16x4 __attribute__((ext_vector_type(4)));
typedef short v4i16_t __attribute__((ext_vector_type(4)));
typedef __attribute__((address_space(3))) const char* lds_cptr;
typedef float f32x2_t __attribute__((ext_vector_type(2))); typedef __bf16 bf16x2_t __attribute__((ext_vector_type(2)));
constexpr float C2 = 0.125f * 1.4426950408889634f;
constexpr float THR = 8.f;
constexpr int L_K = 0, L_V = 16384, L_W = 32768, WSZ = 8448;
__device__ __forceinline__ int crow(int r, int hi) { return (r & 3) + 8 * (r >> 2) + 4 * hi; }
__device__ __forceinline__ unsigned cvtpk(float lo, float hi) { f32x2_t v = {lo, hi}; bf16x2_t b = __builtin_convertvector(v, bf16x2_t); return __builtin_bit_cast(unsigned, b); }
__device__ __forceinline__ s16x4 vtr(lds_cptr p) { return __builtin_bit_cast(s16x4, __builtin_amdgcn_ds_read_tr16_b64_v4i16((__attribute__((address_space(3))) v4i16_t*)p)); }
__device__ __forceinline__ float xhalf_max(float m) { auto rr = __builtin_amdgcn_permlane32_swap(__float_as_uint(m), __float_as_uint(m), false, false); return fmaxf(__uint_as_float(rr[0]), __uint_as_float(rr[1])); }
__device__ __forceinline__ float xhalf_sum(float m) { auto rr = __builtin_amdgcn_permlane32_swap(__float_as_uint(m), __float_as_uint(m), false, false); return __uint_as_float(rr[0]) + __uint_as_float(rr[1]); }
__device__ __forceinline__ float quad_sum(float v) {
    v += __int_as_float(__builtin_amdgcn_mov_dpp(__float_as_int(v), 0xB1, 0xf, 0xf, true));
    v += __int_as_float(__builtin_amdgcn_mov_dpp(__float_as_int(v), 0x4E, 0xf, 0xf, true));
    return v;
}
struct Src { const GAS bf16* k; const GAS bf16* v; int pitch; };

__device__ __forceinline__ void stage_load(const Src& S, int key0, int tid, u32x4& rk, u32x4& rv) {
    const int w = tid >> 6, lane = tid & 63;
    rk = *(const GAS u32x4*)(S.k + (size_t)(key0 + lane) * S.pitch + w * 8);
    rv = *(const GAS u32x4*)(S.v + (size_t)(key0 + 16 * (w & 3) + (lane >> 2)) * S.pitch + (w >> 2) * 32 + (lane & 3) * 8);
}
__device__ __forceinline__ void qk_tile(lds_cptr kslot, const bf16x8 (&qr)[4], float cinit, int r32, int hi, f32x16& p0, f32x16& p1) {
    lds_cptr kp = kslot + hi * 1024 + r32 * 16;
    bf16x8 kf[8];
#pragma unroll
    for (int d0 = 0; d0 < 4; ++d0) { kf[2 * d0] = *(const __attribute__((address_space(3))) bf16x8*)(kp + d0 * 2048); kf[2 * d0 + 1] = *(const __attribute__((address_space(3))) bf16x8*)(kp + d0 * 2048 + 512); }
    f32x16 c;
#pragma unroll
    for (int i = 0; i < 16; ++i) c[i] = cinit;
    p0 = __builtin_amdgcn_mfma_f32_32x32x16_bf16(kf[0], qr[0], c, 0, 0, 0); p1 = __builtin_amdgcn_mfma_f32_32x32x16_bf16(kf[1], qr[0], c, 0, 0, 0);
#pragma unroll
    for (int d0 = 1; d0 < 4; ++d0) { p0 = __builtin_amdgcn_mfma_f32_32x32x16_bf16(kf[2 * d0], qr[d0], p0, 0, 0, 0); p1 = __builtin_amdgcn_mfma_f32_32x32x16_bf16(kf[2 * d0 + 1], qr[d0], p1, 0, 0, 0); }
}
__device__ __forceinline__ void pv_tile(lds_cptr vslot, const f32x16& p0, const f32x16& p1, f32x16 (&o)[2], int lane, int hi) {
    lds_cptr vp = vslot + ((lane >> 4) & 1) * 32 + (lane & 3) * 8 + (4 * hi + ((lane & 15) >> 2)) * 64;
    u32x4 pw[4];
    pw[0] = (u32x4){cvtpk(p0[0], p0[1]), cvtpk(p0[2], p0[3]), cvtpk(p0[4], p0[5]), cvtpk(p0[6], p0[7])};
    pw[1] = (u32x4){cvtpk(p0[8], p0[9]), cvtpk(p0[10], p0[11]), cvtpk(p0[12], p0[13]), cvtpk(p0[14], p0[15])};
    pw[2] = (u32x4){cvtpk(p1[0], p1[1]), cvtpk(p1[2], p1[3]), cvtpk(p1[4], p1[5]), cvtpk(p1[6], p1[7])};
    pw[3] = (u32x4){cvtpk(p1[8], p1[9]), cvtpk(p1[10], p1[11]), cvtpk(p1[12], p1[13]), cvtpk(p1[14], p1[15])};
#pragma unroll
    for (int d0 = 0; d0 < 2; ++d0)
#pragma unroll
        for (int ks = 0; ks < 4; ++ks) { const s16x4 lo = vtr(vp + d0 * 4096 + ks * 1024), hh = vtr(vp + d0 * 4096 + ks * 1024 + 512);
            const bf16x8 vf = (bf16x8){lo[0], lo[1], lo[2], lo[3], hh[0], hh[1], hh[2], hh[3]};
            o[d0] = __builtin_amdgcn_mfma_f32_32x32x16_bf16(__builtin_bit_cast(bf16x8, pw[ks]), vf, o[d0], 0, 0, 0); }
}
__device__ __forceinline__ void mask_tile(f32x16& p0, f32x16& p1, int hi, int lo_lim, int hi_lim, bool rowok) {
    const float NEG = -INFINITY;
#pragma unroll
    for (int r = 0; r < 16; ++r) { const int k0 = crow(r, hi); if (!rowok || k0 < lo_lim || k0 > hi_lim) p0[r] = NEG; if (!rowok || k0 + 32 < lo_lim || k0 + 32 > hi_lim) p1[r] = NEG; }
}
__device__ __forceinline__ float rowmax32(const f32x16& p0, const f32x16& p1) {
    float a = fmaxf(p0[0], p1[0]);
#pragma unroll
    for (int r = 1; r < 16; ++r) a = fmaxf(a, fmaxf(p0[r], p1[r]));
    return xhalf_max(a);
}
struct FState { float mhat, l; f32x16 o[2]; };
template <bool WITH_O>
__device__ __forceinline__ void softmax_step(FState& st, f32x16& p0, f32x16& p1, bool first, LAS float* wsf, int r32, int hi) {
    const float rm = rowmax32(p0, p1);
    float dl = 0.f; bool doit;
    if (first) { doit = true; dl = (rm == -INFINITY) ? 0.f : rm; }
    else { doit = __any(rm > THR); if (doit) dl = fmaxf(rm, 0.f); }
    if (doit) {
        st.mhat += dl;
#pragma unroll
        for (int r = 0; r < 16; ++r) { p0[r] -= dl; p1[r] -= dl; }
        if (!first) { const float f = __builtin_amdgcn_exp2f(-dl); st.l *= f;
            if (WITH_O) { if (hi == 0) wsf[r32] = f; asm volatile("s_waitcnt lgkmcnt(0)" ::: "memory");
#pragma unroll
                for (int a = 0; a < 4; ++a) { const f32x4 fv = *(const LAS f32x4*)(wsf + 8 * a + 4 * hi);
#pragma unroll
                    for (int e = 0; e < 4; ++e) { st.o[0][4 * a + e] *= fv[e]; st.o[1][4 * a + e] *= fv[e]; } } } }
    }
    float s = 0.f;
#pragma unroll
    for (int r = 0; r < 16; ++r) { p0[r] = __builtin_amdgcn_exp2f(p0[r]); p1[r] = __builtin_amdgcn_exp2f(p1[r]); s += p0[r] + p1[r]; }
    st.l += s;
}

__device__ __forceinline__ void nsa_unit(const Params& P, unsigned char* wsb_, LAS unsigned char* ldsg, int tid, int j, int b, int g, int qt) {
    GAS unsigned char* wsb = (GAS unsigned char*)wsb_;
    const int lane = tid & 63, w = __builtin_amdgcn_readfirstlane(tid >> 6), r32 = lane & 31, hi = lane >> 5, tok = r32 >> 2, rh = r32 & 3;
    const int q0 = qt * 64, tl = 8 * w + tok, t = q0 + tl;
    const GAS bf16* Z = (const GAS bf16*)(wsb + WS_Z); GAS bf16* MIX = (GAS bf16*)(wsb + WS_MIX);
    const GAS bf16* Zb = Z + (size_t)b * SEQ * NABP;
    lds_cptr l3 = (lds_cptr)ldsg;
    LAS unsigned char* wreg = ldsg + L_W + w * WSZ; LAS float* GS = (LAS float*)wreg; LAS float* LAST = GS + 1024; LAS float* OACC = (LAS float*)wreg; LAS float* wsf = (LAS float*)(wreg + 8192); LAS unsigned* SELM = (LAS unsigned*)(wreg + 8320);
    bf16x8 qr[4];
    { const GAS bf16* qp = Zb + (size_t)t * NABP + C_QN + (g * 4 + rh) * 64 + hi * 8;
#pragma unroll
      for (int d0 = 0; d0 < 4; ++d0) qr[d0] = *(const GAS bf16x8*)(qp + d0 * 16); }
    float gate[3];
#pragma unroll
    for (int q = 0; q < 3; ++q) gate[q] = sigmoidf_(bf2f(Zb[(size_t)t * NABP + C_GN + (g * 4 + rh) * 3 + q]));
#pragma unroll
    for (int i = 0; i < 8; ++i) *(LAS f32x4*)(GS + (i * 64 + lane) * 4) = (f32x4){0.f, 0.f, 0.f, 0.f};
    u32x4 rk, rv;
    auto run = [&](const Src& S, int jt0, int nt, auto&& body) {
        stage_load(S, jt0 * 64, tid, rk, rv);
        *(LAS u32x4*)(ldsg + L_K + tid * 16) = rk; *(LAS u32x4*)(ldsg + L_V + tid * 16) = rv;
        __syncthreads();
        for (int i = 0; i < nt; ++i) {
            const int sl = (i & 1) * 8192;
            if (i + 1 < nt) stage_load(S, (jt0 + i + 1) * 64, tid, rk, rv);
            body(jt0 + i, i == 0, l3 + L_K + sl, l3 + L_V + sl);
            if (i + 1 < nt) { *(LAS u32x4*)(ldsg + L_K + (sl ^ 8192) + tid * 16) = rk; *(LAS u32x4*)(ldsg + L_V + (sl ^ 8192) + tid * 16) = rv; }
            __syncthreads();
        }
    };
    auto finish = [&](FState& st, float gt, bool first_branch, bool prenorm) {
        float sc = gt;
        if (!prenorm) { const float l = xhalf_sum(st.l); sc = l > 0.f ? gt / l : 0.f; }
        if (hi == 0) wsf[r32] = sc;
        asm volatile("s_waitcnt lgkmcnt(0)" ::: "memory");
#pragma unroll
        for (int a = 0; a < 4; ++a) { const f32x4 fv = *(const LAS f32x4*)(wsf + 8 * a + 4 * hi);
#pragma unroll
            for (int e = 0; e < 4; ++e) { const int q = 8 * a + 4 * hi + e;
#pragma unroll
                for (int d0 = 0; d0 < 2; ++d0) { LAS float* op = OACC + q * 64 + d0 * 32 + r32; const float v = st.o[d0][4 * a + e] * fv[e]; if (first_branch) *op = v; else *op += v; } } }
        asm volatile("s_waitcnt lgkmcnt(0)" ::: "memory");
    };

    const int ncv = t >= 31 ? (((t - 31) >> 4) + 1 > 511 ? 511 : ((t - 31) >> 4) + 1) : 0;
    const int ncmax = (q0 + 63 - 31) >= 0 ? ((q0 + 63 - 31) >> 4) + 1 : 0;
    const int nct = ncmax > 511 ? 8 : (ncmax + 63) >> 6;
    const GAS bf16* KCB = (const GAS bf16*)(wsb + WS_KCB);
    Src SC{KCB + ((size_t)(0 * 2 + b) * 1024 + g) * 64, KCB + ((size_t)(1 * 2 + b) * 1024 + g) * 64, 128};
    FState sc_; sc_.mhat = 0.f; sc_.l = 0.f; sc_.o[0] = f32x16{}; sc_.o[1] = f32x16{};
    if (nct > 0) {
        run(SC, 0, nct, [&](int ct, bool first, lds_cptr ks, lds_cptr) {
            f32x16 p0, p1; qk_tile(ks, qr, -sc_.mhat, r32, hi, p0, p1);
            mask_tile(p0, p1, hi, 0, ncv - 64 * ct - 1, true);
            softmax_step<false>(sc_, p0, p1, first, wsf, r32, hi);
        });
        const float lt = xhalf_sum(sc_.l), invl = lt > 0.f ? 1.f / lt : 0.f;
        run(SC, 0, nct, [&](int ct, bool, lds_cptr ks, lds_cptr vs) {
            f32x16 p0, p1; qk_tile(ks, qr, -sc_.mhat, r32, hi, p0, p1);
            mask_tile(p0, p1, hi, 0, ncv - 64 * ct - 1, true);
#pragma unroll
            for (int r = 0; r < 16; ++r) { p0[r] = __builtin_amdgcn_exp2f(p0[r]) * invl; p1[r] = __builtin_amdgcn_exp2f(p1[r]) * invl; }
#pragma unroll
            for (int qd = 0; qd < 4; ++qd) {
                const float g0 = quad_sum((p0[4 * qd] + p0[4 * qd + 1]) + (p0[4 * qd + 2] + p0[4 * qd + 3])), l0 = quad_sum(p0[4 * qd + 3]);
                const float g1 = quad_sum((p1[4 * qd] + p1[4 * qd + 1]) + (p1[4 * qd + 2] + p1[4 * qd + 3])), l1 = quad_sum(p1[4 * qd + 3]);
                if (rh == 0) { const int m = 16 * ct + 2 * qd + hi; GS[tok * 128 + m] = g0; LAST[tok * 128 + m] = l0; GS[tok * 128 + m + 8] = g1; LAST[tok * 128 + m + 8] = l1; }
            }
            pv_tile(vs, p0, p1, sc_.o, lane, hi);
        });
    }
    unsigned selw[4];
    {
        const int nforced = qt >= 2 ? 3 : qt + 1, nfree = 16 - nforced, ncand = qt - 2;
        asm volatile("s_waitcnt lgkmcnt(0)" ::: "memory");
        if (ncand <= nfree) {
#pragma unroll
            for (int q = 0; q < 4; ++q) { const int lo = 32 * q; selw[q] = qt >= lo + 31 ? 0xffffffffu : (qt < lo ? 0u : ((2u << (qt - lo)) - 1u)); }
        } else {
            for (int tk = 0; tk < 8; ++tk) {
                LAS float* gsr = GS + tk * 128; const LAS float* lsr = LAST + tk * 128;
                const int j0 = lane, j1 = lane + 64;
                float v0 = gsr[j0] + (j0 > 0 ? lsr[j0 - 1] : 0.f), v1 = gsr[j1] + lsr[j1 - 1];
                const bool c0 = j0 >= 1 && j0 <= qt - 2, c1 = j1 <= qt - 2;
                asm volatile("s_waitcnt lgkmcnt(0)" ::: "memory");
                gsr[j0] = v0; gsr[j1] = v1;
                asm volatile("s_waitcnt lgkmcnt(0)" ::: "memory");
                int rk0 = 0, rk1 = 0;
                for (int jj = 0; jj <= qt - 2; jj += 4) { const f32x4 v4 = *(const LAS f32x4*)(gsr + jj);
#pragma unroll
                    for (int e = 0; e < 4; ++e) { const int jx = jj + e; if (jx >= 1 && jx <= qt - 2) { rk0 += (v4[e] > v0 || (v4[e] == v0 && jx < j0)) ? 1 : 0; rk1 += (v4[e] > v1 || (v4[e] == v1 && jx < j1)) ? 1 : 0; } } }
                const bool s0 = (j0 == 0) || (j0 == qt) || (j0 == qt - 1) || (c0 && rk0 < nfree);
                const bool s1 = (j1 == qt) || (j1 == qt - 1) || (c1 && rk1 < nfree);
                const unsigned long long b0 = __ballot(s0), b1 = __ballot(s1);
                if (lane == 0) { SELM[tk * 4] = (unsigned)b0; SELM[tk * 4 + 1] = (unsigned)(b0 >> 32); SELM[tk * 4 + 2] = (unsigned)b1; SELM[tk * 4 + 3] = (unsigned)(b1 >> 32); }
            }
            asm volatile("s_waitcnt lgkmcnt(0)" ::: "memory");
#pragma unroll
            for (int q = 0; q < 4; ++q) selw[q] = SELM[tok * 4 + q];
        }
    }
    finish(sc_, gate[0], true, true);
    {
        Src SS{Zb + C_KV + 256 + g * 64, Zb + C_KV + 384 + g * 64, NABP};
        FState st; st.mhat = 0.f; st.l = 0.f; st.o[0] = f32x16{}; st.o[1] = f32x16{};
        run(SS, 0, qt + 1, [&](int jt, bool first, lds_cptr ks, lds_cptr vs) {
            const unsigned wsel = jt < 32 ? selw[0] : jt < 64 ? selw[1] : jt < 96 ? selw[2] : selw[3];
            const bool rowok = (wsel >> (jt & 31)) & 1u;
            if (__ballot(rowok) == 0ull) return;
            f32x16 p0, p1; qk_tile(ks, qr, -st.mhat, r32, hi, p0, p1);
            if (jt == qt || __ballot(!rowok) != 0ull) mask_tile(p0, p1, hi, 0, jt == qt ? tl : 63, rowok);
            softmax_step<true>(st, p0, p1, first, wsf, r32, hi);
            pv_tile(vs, p0, p1, st.o, lane, hi);
        });
        finish(st, gate[1], false, false);
    }
    {
        Src SW{Zb + C_WIN + g * 64, Zb + C_WIN + 128 + g * 64, NABP};
        FState st; st.mhat = 0.f; st.l = 0.f; st.o[0] = f32x16{}; st.o[1] = f32x16{};
        const int jw0 = qt >= 8 ? qt - 8 : 0;
        run(SW, jw0, qt - jw0 + 1, [&](int jt, bool first, lds_cptr ks, lds_cptr vs) {
            f32x16 p0, p1; qk_tile(ks, qr, -st.mhat, r32, hi, p0, p1);
            if (jt == qt || jt == qt - 8) mask_tile(p0, p1, hi, jt == qt - 8 ? tl : 0, jt == qt ? tl : 63, true);
            softmax_step<true>(st, p0, p1, first, wsf, r32, hi);
            pv_tile(vs, p0, p1, st.o, lane, hi);
        });
        finish(st, gate[2], false, false);
    }
#pragma unroll
    for (int i = 0; i < 4; ++i) { const int q = i * 8 + (lane >> 3), d = (lane & 7) * 8; const f32x4 a = *(const LAS f32x4*)(OACC + q * 64 + d), c = *(const LAS f32x4*)(OACC + q * 64 + d + 4);
        u32x4 o; o.x = cvtpk(a[0], a[1]); o.y = cvtpk(a[2], a[3]); o.z = cvtpk(c[0], c[1]); o.w = cvtpk(c[2], c[3]);
        *(GAS u32x4*)(MIX + (size_t)(b * SEQ + q0 + 8 * w + (q >> 2)) * 1024 + 512 + (g * 4 + (q & 3)) * 64 + d) = o; }
    asm volatile("s_waitcnt lgkmcnt(0)" ::: "memory");
    __syncthreads();
}
}

__device__ __forceinline__ void job_nsa_mfma(const Params& P, const Ctx& C0, int j) { unsigned char* const wsb = launder(P.ws); const Ctx C = relaunder(C0);
    for (int u = C.bid; u < 256; u += C.G) {
        const int bg = u >> 6, s = u & 63;
        nsa::nsa_unit(P, wsb, C.ldsl, C.tid, j, bg >> 1, bg & 1, 127 - s);
        nsa::nsa_unit(P, wsb, C.ldsl, C.tid, j, bg >> 1, bg & 1, s);
    }
}

struct KeyRef { const void* k; const void* v; bool valid; };
template <bool F32>
__device__ __forceinline__ void load8f(const void* p, int off, float (&o)[8]) {
    if (F32) { const f32x4 a = *(const f32x4*)((const float*)p + off), b = *(const f32x4*)((const float*)p + off + 4); o[0] = a[0]; o[1] = a[1]; o[2] = a[2]; o[3] = a[3]; o[4] = b[0]; o[5] = b[1]; o[6] = b[2]; o[7] = b[3]; }
    else unpack8(*(const u32x4*)((const bf16*)p + off), o);
}
template <bool F32, class KF>
__device__ __forceinline__ void attn_branch(const KF& kf, int nk, const f32x4* qs, f32x4* sc, int lane, float (&o)[4], float (&inv)[4]) {
    float mx[4] = {-INFINITY, -INFINITY, -INFINITY, -INFINITY};
    for (int c0 = 0; c0 < nk; c0 += 64) {
        const int idx = c0 + lane; KeyRef kr; kr.valid = false; kr.k = nullptr; kr.v = nullptr;
        if (idx < nk) kr = kf(idx);
        float s[4] = {-INFINITY, -INFINITY, -INFINITY, -INFINITY};
        if (kr.valid) { s[0] = s[1] = s[2] = s[3] = 0.f;
#pragma unroll 2
            for (int d8 = 0; d8 < 8; ++d8) { float kk[8]; load8f<F32>(kr.k, d8 * 8, kk);
#pragma unroll
                for (int i = 0; i < 8; ++i) { const f32x4 q4 = qs[d8 * 8 + i]; s[0] += kk[i] * q4[0]; s[1] += kk[i] * q4[1]; s[2] += kk[i] * q4[2]; s[3] += kk[i] * q4[3]; } } }
        sc[idx] = (f32x4){s[0], s[1], s[2], s[3]};
#pragma unroll
        for (int r = 0; r < 4; ++r) mx[r] = fmaxf(mx[r], s[r]);
    }
    float sum[4] = {0.f, 0.f, 0.f, 0.f};
#pragma unroll
    for (int r = 0; r < 4; ++r) { mx[r] = wave_max(mx[r]); if (mx[r] == -INFINITY) mx[r] = 0.f; }
    for (int c0 = 0; c0 < nk; c0 += 64) { const int idx = c0 + lane; f32x4 s = sc[idx];
#pragma unroll
        for (int r = 0; r < 4; ++r) { s[r] = __expf(s[r] - mx[r]); sum[r] += s[r]; }
        sc[idx] = s; }
#pragma unroll
    for (int r = 0; r < 4; ++r) { sum[r] = wave_sum(sum[r]); inv[r] = sum[r] > 0.f ? 1.f / sum[r] : 1.f; o[r] = 0.f; }
    asm volatile("s_waitcnt lgkmcnt(0)" ::: "memory");
#pragma unroll 4
    for (int jj = 0; jj < nk; ++jj) {
        const KeyRef kr = kf(jj);
        if (!kr.valid) continue;
        const f32x4 p = sc[jj];
        const float vv = F32 ? ((const float*)kr.v)[lane] : bf2f(((const bf16*)kr.v)[lane]);
        o[0] += p[0] * vv; o[1] += p[1] * vv; o[2] += p[2] * vv; o[3] += p[3] * vv;
    }
#pragma unroll
    for (int r = 0; r < 4; ++r) o[r] *= inv[r];
}

__device__ __forceinline__ int nsa_select(const f32x4* sc, const float (&inv)[4], int ncv, int cur, int* sel, int lane) {
    float c[2];
#pragma unroll
    for (int q = 0; q < 2; ++q) { const int jb = lane + 64 * q; float a = 0.f;
        for (int n = 4 * jb - 1; n <= 4 * jb + 3; ++n) if (n >= 0 && n < ncv) { const f32x4 p = sc[n]; a += p[0] * inv[0] + p[1] * inv[1] + p[2] * inv[2] + p[3] * inv[3]; }
        c[q] = (jb >= 1 && jb <= cur - 2) ? a : -1.f; }
    int cnt = 0;
    if (lane == 0) { sel[cnt] = 0; } cnt++;
    if (cur >= 1) { if (lane == 0) sel[cnt] = cur; cnt++; }
    if (cur >= 2) { if (lane == 0) sel[cnt] = cur - 1; cnt++; }
    const int nfree = 16 - cnt;
    for (int it = 0; it < nfree; ++it) {
        float bv = c[0]; int bi = lane; if (c[1] > bv) { bv = c[1]; bi = lane + 64; }
#pragma unroll
        for (int o = 1; o < 64; o <<= 1) { const float ov = __shfl_xor(bv, o); const int oi = __shfl_xor(bi, o); if (ov > bv || (ov == bv && oi < bi)) { bv = ov; bi = oi; } }
        if (bv < 0.f) break;
        if (lane == 0) sel[cnt] = bi;
        cnt++;
        if (bi == lane) c[0] = -2.f; if (bi == lane + 64) c[1] = -2.f;
    }
    asm volatile("s_waitcnt lgkmcnt(0)" ::: "memory");
    return cnt;
}

template <bool DEC>
__device__ __forceinline__ void job_nsa_naive(const Params& P, const Ctx& C0, int j) { unsigned char* const wsb = launder(P.ws); const Ctx C = relaunder(C0);
    const bf16* Z = (const bf16*)(wsb + WS_Z); bf16* MIX = (bf16*)(wsb + WS_MIX);
    const float* KC = DEC ? (const float*)(wsb + WS_KCS) + (size_t)j * 2 * 32 * 512 * 128 : (const float*)(wsb + WS_KC);
    const int NB = DEC ? 32 : 2;
    const float* VC = KC + (size_t)NB * 512 * 128;
    f32x4* qs = (f32x4*)(C.lds + C.wave * 17664); f32x4* sc = qs + 64; int* sel = (int*)(sc + 1024 + 8);
    const int lane = C.lane, gw = C.bid * NWAVES + C.wave, NGW = C.G * NWAVES;
    const int nunit = DEC ? 32 * 4 * 2 : MP * 2;
    for (int u = gw; u < nunit; u += NGW) {
        const int g = u & 1, bt_ = u >> 1, b = DEC ? (bt_ >> 2) : (bt_ >> 13), t = DEC ? (bt_ & 3) : (bt_ & 8191);
        const int row = DEC ? MP + bt_ : bt_, qpos = DEC ? SEQ + t : t;
        const bf16* zr = Z + (size_t)row * NABP;
        { f32x4 q4;
#pragma unroll
          for (int r = 0; r < 4; ++r) q4[r] = bf2f(zr[C_QN + (g * 4 + r) * 64 + lane]) * 0.6931471805599453f;
          qs[lane] = q4; }
        asm volatile("s_waitcnt lgkmcnt(0)" ::: "memory");
        float gt[4][3];
#pragma unroll
        for (int r = 0; r < 4; ++r)
#pragma unroll
            for (int q = 0; q < 3; ++q) gt[r][q] = sigmoidf_(bf2f(zr[C_GN + (g * 4 + r) * 3 + q]));
        float oc[4], os[4], ow[4], inv[4];
        const int ncv = DEC ? 511 : (qpos >= 31 ? (((qpos - 31) >> 4) + 1 > 511 ? 511 : ((qpos - 31) >> 4) + 1) : 0);
        { auto kf = [&](int idx) -> KeyRef { KeyRef k; const size_t o = ((size_t)(b * 512 + idx) * 2 + g) * 64; k.k = KC + o; k.v = VC + o; k.valid = idx < ncv; return k; };
          attn_branch<true>(kf, ncv, qs, sc, lane, oc, inv); }
        const int cur = qpos >> 6;
        const int nsel = nsa_select(sc, inv, ncv, cur, sel, lane);
        { auto kf = [&](int idx) -> KeyRef { KeyRef k; const int blk = sel[idx >> 6], pos = blk * 64 + (idx & 63); k.valid = pos <= qpos;
              if (DEC) { const float* base;
                  if (pos < SEQ) { const int page = P.page_table[b * 64 + (pos >> 7)]; base = P.cache + ((((size_t)j * NPOOL + page) * 128 + (pos & 127)) * 4 + 2) * 128 + g * 64; }
                  else base = P.out + O_SKV + (((size_t)(j * 32 + b) * 4 + (pos - SEQ > 3 ? 3 : pos - SEQ)) * 4 + 2) * 128 + g * 64;
                  k.k = base; k.v = base + 128; }
              else { const bf16* base = Z + (size_t)(b * SEQ + pos) * NABP + C_KV + 256 + g * 64; k.k = base; k.v = base + 128; }
              return k; };
          attn_branch<DEC>(kf, nsel * 64, qs, sc, lane, os, inv); }
        { auto kf = [&](int idx) -> KeyRef { KeyRef k;
              if (DEC) { k.valid = idx >= t && idx <= 512 + t;
                  const float* base = idx < 4 ? P.st_win + (((size_t)(j * 32 + b) * 512 + idx) * 2) * 128 + g * 64 : P.out + O_SWIN + (((size_t)(j * 32 + b) * 512 + (idx - 4)) * 2) * 128 + g * 64;
                  k.k = base; k.v = base + 128; }
              else { const int pos = qpos - 512 + idx; k.valid = pos >= 0; const bf16* base = Z + (size_t)(b * SEQ + (pos < 0 ? 0 : pos)) * NABP + C_WIN + g * 64; k.k = base; k.v = base + 128; }
              return k; };
          attn_branch<DEC>(kf, DEC ? 516 : 513, qs, sc, lane, ow, inv); }
#pragma unroll
        for (int r = 0; r < 4; ++r) MIX[(size_t)row * 1024 + 512 + (g * 4 + r) * 64 + lane] = (bf16)f2bf(gt[r][0] * oc[r] + gt[r][1] * os[r] + gt[r][2] * ow[r]);
    }
}

__device__ __forceinline__ void job_gate_prompt(const Params& P, const Ctx& C0, int jc) { unsigned char* const wsb = launder(P.ws); const Ctx C = relaunder(C0);
    const bf16* Z2 = (const bf16*)(wsb + WS_Z); bf16* MIX = (bf16*)(wsb + WS_MIX);
    bf16* vh = (bf16*)C.lds;
    float* wsl = (float*)(C.lds + 65536);
    float* rstd = (float*)(C.lds + 131072);
    const int tid = C.tid;
    for (int u = C.bid; u < 512; u += C.G) {
        const int ch = u >> 2, gq = u & 3, r0 = ch * 128;
        __syncthreads();
        for (int rr = C.wave; rr < 128; rr += NWAVES) { const bf16* vr = Z2 + (size_t)(r0 + rr) * 2048 + 1024; float a[8], b[8]; unpack8(*(const u32x4*)(vr + C.lane * 16), a); unpack8(*(const u32x4*)(vr + C.lane * 16 + 8), b);
            float s = 0.f;
#pragma unroll
            for (int e = 0; e < 8; ++e) s += a[e] * a[e] + b[e] * b[e];
            s = wave_sum(s); if (C.lane == 0) rstd[rr] = rsqrtf(s * (1.f / 1024.f) + EPSN); }
        for (int i = tid; i < 4096; i += NTHR) ((f32x4*)wsl)[i] = ((const f32x4*)(P.cl_ws + (size_t)(jc * 4 + gq) * 16384))[i];
        __syncthreads();
        for (int i = tid; i < 128 * 32; i += NTHR) { const int s = i >> 5, d0 = (i & 31) * 8; float a[8]; unpack8(*(const u32x4*)(Z2 + (size_t)(r0 + s) * 2048 + 1024 + gq * 256 + d0), a);
            const float rs = rstd[s]; const float* gv = P.cl_v_g + jc * 1024 + gq * 256 + d0; u32x4 w;
            w.x = pk2(a[0] * rs * gv[0], a[1] * rs * gv[1]); w.y = pk2(a[2] * rs * gv[2], a[3] * rs * gv[3]); w.z = pk2(a[4] * rs * gv[4], a[5] * rs * gv[5]); w.w = pk2(a[6] * rs * gv[6], a[7] * rs * gv[7]);
            *(u32x4*)(vh + s * 256 + d0) = w; }
        __syncthreads();
        const int t0 = (tid >> 5) * 8, d0 = (tid & 31) * 8;
        float acc[8][8];
#pragma unroll
        for (int a = 0; a < 8; ++a)
#pragma unroll
            for (int e = 0; e < 8; ++e) acc[a][e] = 0.f;
        for (int s = 0; s < t0 + 8; ++s) { float v8[8]; unpack8(*(const u32x4*)(vh + s * 256 + d0), v8);
#pragma unroll
            for (int a = 0; a < 8; ++a) { const float w = (s <= t0 + a) ? wsl[(t0 + a) * 128 + s] : 0.f;
#pragma unroll
                for (int e = 0; e < 8; ++e) acc[a][e] += w * v8[e]; } }
#pragma unroll
        for (int a = 0; a < 8; ++a) { const int t = t0 + a; const float bs = P.cl_bs[(jc * 4 + gq) * 128 + t]; float uu[8]; unpack8(*(const u32x4*)(Z2 + (size_t)(r0 + t) * 2048 + gq * 256 + d0), uu);
            u32x4 w; w.x = pk2(uu[0] * (acc[a][0] + bs), uu[1] * (acc[a][1] + bs)); w.y = pk2(uu[2] * (acc[a][2] + bs), uu[3] * (acc[a][3] + bs));
            w.z = pk2(uu[4] * (acc[a][4] + bs), uu[5] * (acc[a][5] + bs)); w.w = pk2(uu[6] * (acc[a][6] + bs), uu[7] * (acc[a][7] + bs));
            *(u32x4*)(MIX + (size_t)(r0 + t) * 1024 + gq * 256 + d0) = w; }
    }
    __syncthreads();
}
__device__ __forceinline__ void job_gate_sample(const Params& P, const Ctx& C0, int jc) { unsigned char* const wsb = launder(P.ws); const Ctx C = relaunder(C0);
    const bf16* Z2 = (const bf16*)(wsb + WS_Z); bf16* MIX = (bf16*)(wsb + WS_MIX);
    float* vh = (float*)C.lds; float* red = vh + 4096;
    const int tid = C.tid;
    for (int u = C.bid; u < 32; u += C.G) {
        const int r0 = MP + u * 4;
        __syncthreads();
        float v[8];
#pragma unroll
        for (int i = 0; i < 8; ++i) { const int idx = i * 512 + tid, t = idx >> 10, c = idx & 1023; v[i] = bf2f(Z2[(size_t)(r0 + t) * 2048 + 1024 + c]); }
#pragma unroll
        for (int t = 0; t < 4; ++t) { float s = v[2 * t] * v[2 * t] + v[2 * t + 1] * v[2 * t + 1]; s = wave_sum(s); if (C.lane == 0) red[t * 8 + C.wave] = s; }
        __syncthreads();
#pragma unroll
        for (int i = 0; i < 8; ++i) { const int idx = i * 512 + tid, t = idx >> 10, c = idx & 1023; float s = 0.f;
#pragma unroll
            for (int w = 0; w < 8; ++w) s += red[t * 8 + w];
            const float x = v[i] * rsqrtf(s * (1.f / 1024.f) + EPSN) * P.cl_v_g[jc * 1024 + c]; vh[idx] = x; P.out[O_SGV + ((size_t)(jc * 32 + u) * 4 + t) * 1024 + c] = x; }
        __syncthreads();
#pragma unroll
        for (int i = 0; i < 8; ++i) { const int idx = i * 512 + tid, t = idx >> 10, c = idx & 1023, gq = c >> 8; float s = P.cl_bs[(jc * 4 + gq) * 128 + t];
            for (int sp = 0; sp <= t; ++sp) s += P.cl_ws[(size_t)(jc * 4 + gq) * 16384 + t * 128 + sp] * vh[sp * 1024 + c];
            const float uu = bf2f(Z2[(size_t)(r0 + t) * 2048 + c]); MIX[(size_t)(r0 + t) * 1024 + c] = (bf16)f2bf(uu * s); }
    }
    __syncthreads();
}

#ifndef JOBMASK
#define JOBMASK 0xFFFFFFFFu
#endif
#define EN(n) ((JOBMASK >> (n)) & 1u)
__global__ void __launch_bounds__(NTHR, 2) trunk_fwd(Params P) {
    extern __shared__ __attribute__((aligned(16))) unsigned char lds[];
    Ctx C; C.ldsl = (LAS unsigned char*)lds; C.lds = lds; C.tid = threadIdx.x; C.lane = C.tid & 63; C.wave = __builtin_amdgcn_readfirstlane(C.tid >> 6); C.bid = blockIdx.x; C.G = gridDim.x;
    volatile LAS unsigned* MISC = (volatile LAS unsigned*)((LAS unsigned char*)lds + MISC_OFF);
    if (C.tid < 64) MISC[C.tid] = 0u;
    __syncthreads();
    unsigned* ctl = (unsigned*)(P.ws + WS_CTL);
    const bool multi = (P.ph_hi - P.ph_lo) > 1;
    XcdBarrier bar; bar.bar = ctl + 4096; bar.x = 0; bar.st = nullptr;
    if (multi) bar = xcd_barrier_post(ctl + 4096, MISC + 8);
    const int lo = P.ph_lo, hi = P.ph_hi;
    int ph = 0;
#define IN() (lo <= ph && ph < hi)
#define SEAM() do { if (IN() && ph + 1 < hi) xcd_barrier(bar); ++ph; } while (0)
    LAS unsigned char* ldsl = (LAS unsigned char*)lds;

    if (IN()) { if(EN(0)) job_transposes(P, C); if(EN(1)) job_copy_x(P, C); if(EN(2)) job_adaln(P, C); }
    SEAM();
    if (IN()) { if(EN(3)) job_norm<false>(P, C, 0, 0); if(EN(4)) { job_compress1<true>(P, C, 0); job_compress1<true>(P, C, 1); } }
    SEAM();
    for (int l = 0; l < 4; ++l) {
        const int j = l >> 1;
        if ((l & 1) == 0) {
            if (IN()) { unsigned char* ws = launder(P.ws); pg8::Gemm g{(const bf16*)(ws + WS_H), (const bf16*)(ws + WS_WABIN) + (size_t)j * NABP * DM, MT, NABP, DM}; pg8::StaticOrder S; S.init(MT, NABP, C.G, C.bid);
                pg8::EpiAbIn E{(bf16*)(ws + WS_Z), P.ab_b_in + (size_t)j * NABV, (float*)(ws + WS_GATE), P.out, j};
                if(EN(16)) pg8::gemm_phase<pg8::EpiAbIn, pg8::StaticOrder, true, true>(ldsl, g, S, E); }
            SEAM();
            if (IN()) { if(EN(5)) job_mlstm_local(P, C, j); if(EN(4)) job_compress1<false>(P, C, j); if(EN(6)) job_mlstm_sample(P, C, j); if(EN(7)) job_compress2<true>(P, C, j); }
            SEAM();
            if (IN()) { if(EN(8)) job_mlstm_scan(P, C, j); if(EN(7)) job_compress2<false>(P, C, j); }
            SEAM();
            if (IN()) { if(EN(9)) job_mlstm_out(P, C, j); if(EN(10)) job_nsa_mfma(P, C, j); if(EN(11)) job_nsa_naive<true>(P, C, j); }
            SEAM();
        } else {
            if (IN()) { unsigned char* ws = launder(P.ws); pg8::Gemm g{(const bf16*)(ws + WS_H), (const bf16*)(ws + WS_WCLIN) + (size_t)j * 2048 * DM, MT, 2048, DM}; pg8::StaticOrder S; S.init(MT, 2048, C.G, C.bid);
                pg8::EpiAct<1> E{(bf16*)(ws + WS_Z), 2048, P.cl_b_in + (size_t)j * 2048};
                if(EN(17)) pg8::gemm_phase<pg8::EpiAct<1>, pg8::StaticOrder, true, true>(ldsl, g, S, E); }
            SEAM();
            if (IN()) { if(EN(12)) job_gate_prompt(P, C, j); if(EN(13)) job_gate_sample(P, C, j); }
            SEAM();
        }
        if (IN()) { unsigned char* ws = launder(P.ws); const bf16* Wt = (l & 1) ? (const bf16*)(ws + WS_WCLOUT) + (size_t)j * DM * DM : (const bf16*)(ws + WS_WABOUT) + (size_t)j * DM * DM;
            pg8::Gemm g{(const bf16*)(ws + WS_MIX), Wt, MT, DM, DM}; pg8::StaticOrder S; S.init(MT, DM, C.G, C.bid);
            pg8::EpiResid E{(float*)(ws + WS_X), (const float*)(ws + WS_MOD) + (size_t)l * 34 * 6144 + 2 * DM};
            if(EN(19)) pg8::gemm_phase<pg8::EpiResid, pg8::StaticOrder, true, true>(ldsl, g, S, E); }
        SEAM();
        if (IN()) { if(EN(3)) job_norm<false>(P, C, l, 1); }
        SEAM();
        if (IN()) { unsigned char* ws = launder(P.ws); pg8::Gemm g{(const bf16*)(ws + WS_H), (const bf16*)(ws + WS_WF1) + (size_t)l * FF * DM, MT, FF, DM}; pg8::StaticOrder S; S.init(MT, FF, C.G, C.bid);
            pg8::EpiAct<0> E{(bf16*)(ws + WS_ACT), FF, nullptr};
            if(EN(18)) pg8::gemm_phase<pg8::EpiAct<0>, pg8::StaticOrder, true, true>(ldsl, g, S, E); }
        SEAM();
        if (IN()) { unsigned char* ws = launder(P.ws); pg8::Gemm g{(const bf16*)(ws + WS_ACT), (const bf16*)(ws + WS_WF2) + (size_t)l * DM * FF, MT, DM, FF}; pg8::StaticOrder S; S.init(MT, DM, C.G, C.bid);
            pg8::EpiResid E{(float*)(ws + WS_X), (const float*)(ws + WS_MOD) + (size_t)l * 34 * 6144 + 5 * DM};
            if(EN(19)) pg8::gemm_phase<pg8::EpiResid, pg8::StaticOrder, true, true>(ldsl, g, S, E); }
        SEAM();
        if (IN()) { if(EN(3)) { if (l < 3) job_norm<false>(P, C, l + 1, 0); else job_norm<true>(P, C, 0, 0); } }
        SEAM();
    }
#undef IN
#undef SEAM
}
constexpr int N_PHASES = 2 + 2 * 9 + 2 * 7;

#ifndef MK_ONE_LAUNCH
#define MK_ONE_LAUNCH 1
#endif
extern "C" void kernel_launch(void* const* d_in, const int* in_sizes, int n_in, void* d_out, int out_size, void* d_ws, size_t ws_size, hipStream_t stream) {
    static int grid = 0;
    if (grid == 0) {
        if (n_in != 35 || out_size != (int)O_END || ws_size < WS_END) { fprintf(stderr, "kernel_launch: unexpected shapes (n_in %d out %d ws %zu)\n", n_in, out_size, ws_size); grid = -1; return; }
        int dev = 0, cus = 0, per_cu = 0;
        if (hipGetDevice(&dev) != hipSuccess || hipDeviceGetAttribute(&cus, hipDeviceAttributeMultiprocessorCount, dev) != hipSuccess) { grid = -1; return; }
        if (hipFuncSetAttribute((const void*)trunk_fwd, hipFuncAttributeMaxDynamicSharedMemorySize, LDS_BYTES) != hipSuccess) { fprintf(stderr, "kernel_launch: hipFuncSetAttribute failed\n"); grid = -1; return; }
        if (hipOccupancyMaxActiveBlocksPerMultiprocessor(&per_cu, (const void*)trunk_fwd, NTHR, LDS_BYTES) != hipSuccess || per_cu < 1) { fprintf(stderr, "kernel_launch: occupancy query says %d\n", per_cu); }
        (void)hipGetLastError();
        grid = cus;
    }
    if (grid < 0) return;
    (void)hipMemsetAsync((char*)d_ws + WS_CTL, 0, CTL_ZERO_BYTES, stream);
    Params p{};
    const float** fp = (const float**)&p.x_prompt;
    (void)fp;
    p.x_prompt = (const float*)d_in[0]; p.x_sample = (const float*)d_in[1]; p.c_prompt = (const float*)d_in[2]; p.c_sample = (const float*)d_in[3];
    p.st_conv = (const float*)d_in[4]; p.st_C = (const float*)d_in[5]; p.st_n = (const float*)d_in[6]; p.st_m = (const float*)d_in[7]; p.cache = (const float*)d_in[8]; p.st_win = (const float*)d_in[9];
    p.page_table = (const int*)d_in[10];
    p.ada_w = (const float*)d_in[11]; p.ada_b = (const float*)d_in[12]; p.norm_g = (const float*)d_in[13]; p.ab_w_in = (const float*)d_in[14]; p.ab_b_in = (const float*)d_in[15];
    p.ml_conv_w = (const float*)d_in[16]; p.ml_conv_b = (const float*)d_in[17]; p.ml_f_bias = (const float*)d_in[18]; p.ml_out_g = (const float*)d_in[19];
    p.phi_pe = (const float*)d_in[20]; p.phi_w1 = (const float*)d_in[21]; p.phi_b1 = (const float*)d_in[22]; p.phi_w2 = (const float*)d_in[23]; p.phi_b2 = (const float*)d_in[24];
    p.ab_w_out = (const float*)d_in[25]; p.cl_w_in = (const float*)d_in[26]; p.cl_b_in = (const float*)d_in[27]; p.cl_v_g = (const float*)d_in[28]; p.cl_ws = (const float*)d_in[29]; p.cl_bs = (const float*)d_in[30];
    p.cl_w_out = (const float*)d_in[31]; p.ffn_w1 = (const float*)d_in[32]; p.ffn_w2 = (const float*)d_in[33]; p.final_g = (const float*)d_in[34];
    p.out = (float*)d_out; p.ws = (unsigned char*)d_ws; p.pad = 0;
#if MK_ONE_LAUNCH
    p.ph_lo = 0; p.ph_hi = N_PHASES; p.li = 0;
    hipLaunchKernelGGL(trunk_fwd, dim3(grid), dim3(NTHR), LDS_BYTES, stream, p);
#else
    for (int k = 0; k < N_PHASES; ++k) { p.ph_lo = k; p.ph_hi = k + 1; p.li = k; hipLaunchKernelGGL(trunk_fwd, dim3(grid), dim3(NTHR), LDS_BYTES, stream, p); }
#endif
}
```
